# Optimizing an MI355X kernel written in HIP

```python
import math
import jax, jax.numpy as jnp
from jax import lax
import numpy as np

D_MODEL = 2048
BATCH = 16
SEQ = 256
DEPTH = 1
DEC_BATCH = 2
DEC_SEQ = 4096
PAST_LEN = 512

GRID_W = 64
RET_HEADS = 8
RET_DK = 128
RET_DV = 128
D_RET = RET_HEADS * RET_DV
HG_HEADS = 8
HG_DK = 128
HG_DV = 128
D_HG = HG_HEADS * HG_DV
D_MIX = D_RET + D_HG
N_IN_PARTS = 9
D_IN = N_IN_PARTS * 1024
CHUNK = 64
ROPE_BASE = 10000.0
EPS = 1e-6

kernel_name = 'bidir_retention_hgrn2_hybrid_step'

F32 = jnp.float32


def rms_norm(x, w=None):
    xf = x.astype(F32)
    y = xf * lax.rsqrt(jnp.mean(xf * xf, axis=-1, keepdims=True) + EPS)
    if w is not None:
        y = y * w.astype(F32)
    return y.astype(x.dtype)


def axial_rope(x, row, col):
    half = x.shape[-1] // 2
    nf = half // 2
    freqs = ROPE_BASE ** (-jnp.arange(nf, dtype=F32) / nf)
    def rot(xp, pos):
        ang = pos[:, None] * freqs[None, :]
        cos, sin = jnp.cos(ang), jnp.sin(ang)
        x1, x2 = xp[..., :nf], xp[..., nf:]
        return jnp.concatenate([x1 * cos - x2 * sin, x1 * sin + x2 * cos], axis=-1)
    return jnp.concatenate([rot(x[..., :half], row), rot(x[..., half:], col)], axis=-1)


def to_chunks(t):
    b, h, l, d = t.shape
    return t.reshape(b, h, l // CHUNK, CHUNK, d).transpose(2, 0, 1, 3, 4)


def from_chunks(t):
    n, b, h, c, d = t.shape
    return t.transpose(1, 2, 0, 3, 4).reshape(b, h, n * c, d)


def retention_scan(q, k, v, log_gamma, s0):
    idx = jnp.arange(CHUNK, dtype=F32)
    rel = idx[:, None] - idx[None, :]
    lg = log_gamma.astype(F32)
    intra = jnp.where(rel >= 0, jnp.exp(lg[:, None, None] * jnp.maximum(rel, 0.0)), 0.0)
    q_dec = jnp.exp(lg[:, None] * (idx + 1.0))[:, :, None]
    k_dec = jnp.exp(lg[:, None] * (CHUNK - 1.0 - idx))[:, :, None]
    c_dec = jnp.exp(lg * CHUNK)[:, None, None]

    def step(s, qkv):
        qc, kc, vc = qkv
        scores = jnp.einsum('bhid,bhjd->bhij', qc, kc) * intra
        o = (jnp.einsum('bhij,bhjv->bhiv', scores, vc)
             + jnp.einsum('bhid,bhdv->bhiv', qc * q_dec, s))
        s = s * c_dec + jnp.einsum('bhjd,bhjv->bhdv', kc * k_dec, vc)
        return s, o

    s_fin, o = lax.scan(step, s0.astype(F32), (to_chunks(q), to_chunks(k), to_chunks(v)))
    return from_chunks(o), s_fin


def hgrn2_scan(q, k, v, log_f, s0):
    idx = jnp.arange(CHUNK)
    causal = (idx[:, None] >= idx[None, :])[None, None, :, :, None]

    def step(s, inp):
        qc, kc, vc, lfc = inp
        b = jnp.cumsum(lfc, axis=-2)
        diff = b[:, :, :, None, :] - b[:, :, None, :, :]
        decay = jnp.exp(jnp.where(causal, diff, -jnp.inf))
        scores = jnp.einsum('bhid,bhjd,bhijd->bhij', qc, kc, decay)
        o = (jnp.einsum('bhij,bhjv->bhiv', scores, vc)
             + jnp.einsum('bhid,bhdv->bhiv', qc * jnp.exp(b), s))
        b_last = b[:, :, -1:, :]
        s = (jnp.exp(b_last[:, :, 0, :])[..., None] * s
             + jnp.einsum('bhjd,bhjv->bhdv', kc * jnp.exp(b_last - b), vc))
        return s, o

    s_fin, o = lax.scan(step, s0.astype(F32),
                        (to_chunks(q), to_chunks(k), to_chunks(v), to_chunks(log_f)))
    return from_chunks(o), s_fin


def _flip(t):
    return jnp.flip(t, axis=2)


def hybrid_layer(x, mod, norm_w, w_in, w_out, ret_log_gamma, hg_lb, hg_norm_w, states, pos):
    bsz, seqlen, _ = x.shape
    shift, scale, gate = jnp.split(mod, 3, axis=-1)
    h = rms_norm(x, norm_w)
    h = h * (1.0 + scale[:, None, :]) + shift[:, None, :]
    proj = h @ w_in
    rq, rk, rv, rg, hq, hf_f, hf_b, hi, hg = jnp.split(proj, N_IN_PARTS, axis=-1)

    def heads(t, n):
        return t.astype(F32).reshape(bsz, seqlen, n, -1).transpose(0, 2, 1, 3)

    def merge(t):
        return t.transpose(0, 2, 1, 3).reshape(bsz, seqlen, -1)

    s_rf0, s_rb0, s_hf0, s_hb0 = states

    q_r = heads(rq, RET_HEADS)
    k_r = heads(rk, RET_HEADS) * (RET_DK ** -0.5)
    v_r = heads(rv, RET_HEADS)
    if pos is not None:
        q_r = axial_rope(q_r, pos[0], pos[1])
        k_r = axial_rope(k_r, pos[0], pos[1])
    o_rf, s_rf = retention_scan(q_r, k_r, v_r, ret_log_gamma[0], s_rf0)
    o_rb, s_rb = retention_scan(_flip(q_r), _flip(k_r), _flip(v_r), ret_log_gamma[1], s_rb0)
    o_r = merge(rms_norm(o_rf + _flip(o_rb))) * jax.nn.silu(rg)

    def forget(z, lb):
        f = lb[None, None, :] + (1.0 - lb[None, None, :]) * jax.nn.sigmoid(z.astype(F32))
        return heads(jnp.log(f), HG_HEADS), heads(1.0 - f, HG_HEADS)

    q_h = heads(hq, HG_HEADS)
    v_h = heads(hi, HG_HEADS)
    lf_f, k_f = forget(hf_f, hg_lb[0])
    lf_b, k_b = forget(hf_b, hg_lb[1])
    o_hf, s_hf = hgrn2_scan(q_h, k_f, v_h, lf_f, s_hf0)
    o_hb, s_hb = hgrn2_scan(_flip(q_h), _flip(k_b), _flip(v_h), _flip(lf_b), s_hb0)
    o_h = merge(rms_norm(o_hf + _flip(o_hb), hg_norm_w)) * jax.nn.silu(hg)

    out = jnp.concatenate([o_r, o_h], axis=-1).astype(x.dtype) @ w_out
    x = x + (gate[:, None, :] * out).astype(x.dtype)
    return x, (s_rf, s_rb, s_hf, s_hb)


def setup_inputs(seed: int = 0) -> dict:
    key = jax.random.key(seed)
    ks = jax.random.split(key, 20)
    nrm = jax.random.normal
    state_ret_shape = (DEC_BATCH, DEPTH, RET_HEADS, RET_DK, RET_DV)
    state_hg_shape = (DEC_BATCH, DEPTH, HG_HEADS, HG_DK, HG_DV)
    base_decay = jnp.log(2.0 ** (-5.0 - jnp.arange(RET_HEADS, dtype=F32)))
    return {
        'x_prompt': nrm(ks[0], (BATCH, SEQ, D_MODEL), F32),
        'x_sample': nrm(ks[1], (DEC_BATCH, DEC_SEQ, D_MODEL), F32),
        'state_ret_fwd': nrm(ks[2], state_ret_shape, F32),
        'state_ret_bwd': nrm(ks[3], state_ret_shape, F32),
        'state_hgrn_fwd': nrm(ks[4], state_hg_shape, F32),
        'state_hgrn_bwd': nrm(ks[5], state_hg_shape, F32),
        'c': nrm(ks[6], (DEC_BATCH, D_MODEL), F32),
        'c_ctx': nrm(ks[7], (D_MODEL,), F32),
        'norm_w': 1.0 + 0.02 * nrm(ks[8], (DEPTH, D_MODEL), F32),
        'w_ada': 0.5 * D_MODEL ** -0.5 * nrm(ks[9], (DEPTH, D_MODEL, 3 * D_MODEL), F32),
        'b_ada': 0.02 * nrm(ks[10], (DEPTH, 3 * D_MODEL), F32),
        'w_in': D_MODEL ** -0.5 * nrm(ks[11], (DEPTH, D_MODEL, D_IN), F32),
        'ret_decay': base_decay[None, None, :] + 0.1 * nrm(ks[12], (DEPTH, 2, RET_HEADS), F32),
        'hg_lower_bounds': 0.1 * nrm(ks[13], (2, DEPTH + 1, D_HG), F32),
        'hg_norm_w': 1.0 + 0.02 * nrm(ks[14], (DEPTH, HG_DV), F32),
        'w_out': D_MIX ** -0.5 * nrm(ks[15], (DEPTH, D_MIX, D_MODEL), F32),
        'final_norm_w': 1.0 + 0.02 * nrm(ks[16], (D_MODEL,), F32),
    }


def reference(x_prompt, x_sample, state_ret_fwd, state_ret_bwd, state_hgrn_fwd, state_hgrn_bwd,
              c, c_ctx, norm_w, w_ada, b_ada, w_in, ret_decay, hg_lower_bounds, hg_norm_w,
              w_out, final_norm_w):
    lb_all = jnp.cumsum(jax.nn.softmax(hg_lower_bounds.astype(F32), axis=1), axis=1)

    n_lat = x_sample.shape[1]
    rows = n_lat // GRID_W
    row = jnp.repeat(jnp.arange(rows, dtype=F32), GRID_W)
    col = jnp.tile(jnp.arange(GRID_W, dtype=F32), rows)

    xp = x_prompt
    bp = x_prompt.shape[0]
    zr = jnp.zeros((bp, RET_HEADS, RET_DK, RET_DV), F32)
    zh = jnp.zeros((bp, HG_HEADS, HG_DK, HG_DV), F32)
    st_rf, st_rb, st_hf, st_hb = [], [], [], []
    for l in range(DEPTH):
        log_gamma = jnp.log1p(-jnp.exp(ret_decay[l].astype(F32)))
        mod_ctx = jax.nn.silu(c_ctx)[None, :] @ w_ada[l] + b_ada[l]
        xp, (s_rf, s_rb, s_hf, s_hb) = hybrid_layer(
            xp, mod_ctx, norm_w[l], w_in[l], w_out[l], log_gamma, lb_all[:, l],
            hg_norm_w[l], (zr, zr, zh, zh), None)
        st_rf.append(s_rf); st_rb.append(s_rb); st_hf.append(s_hf); st_hb.append(s_hb)
    new_ret_fwd = jnp.stack(st_rf, axis=1).astype(x_prompt.dtype)
    new_ret_bwd = jnp.stack(st_rb, axis=1).astype(x_prompt.dtype)
    new_hgrn_fwd = jnp.stack(st_hf, axis=1).astype(x_prompt.dtype)
    new_hgrn_bwd = jnp.stack(st_hb, axis=1).astype(x_prompt.dtype)
    y_prompt = rms_norm(xp, final_norm_w)

    xs = x_sample
    for l in range(DEPTH):
        log_gamma = jnp.log1p(-jnp.exp(ret_decay[l].astype(F32)))
        mod_lat = jax.nn.silu(c) @ w_ada[l] + b_ada[l]
        xs, _ = hybrid_layer(
            xs, mod_lat, norm_w[l], w_in[l], w_out[l], log_gamma, lb_all[:, l], hg_norm_w[l],
            (state_ret_fwd[:, l], state_ret_bwd[:, l], state_hgrn_fwd[:, l], state_hgrn_bwd[:, l]),
            (row, col))
    y_sample = rms_norm(xs, final_norm_w)

    return (y_prompt, y_sample, new_ret_fwd, new_ret_bwd, new_hgrn_fwd, new_hgrn_bwd)
```

```cpp
#include <hip/hip_runtime.h>
#include <hip/hip_cooperative_groups.h>
#include <cstdio>
namespace pg8 {
#define PG8_LAS __attribute__((address_space(3)))
typedef unsigned short bf16_t;
typedef short bf16x8 __attribute__((ext_vector_type(8)));
typedef float f32x4 __attribute__((ext_vector_type(4)));
typedef unsigned u32x4 __attribute__((ext_vector_type(4)));
constexpr int BM = 256, BK = 64, HALF = 128, HTB = HALF * BK * 2  , STAGE_BYTES = 8 * HTB, NXCD = 8, WGM = 8;

__host__ __device__ __forceinline__ int lds_byte(int r, int c) { const int st = (r >> 4) * 2 + (c >> 5), rr = r & 15, cc = c & 31, ob = rr * 64 + cc * 2; return st * 1024 + (ob ^ (((ob >> 9) & 1) << 5)); }
__host__ __device__ __forceinline__ void stage_rc(int b, int& R, int& C) { const int st = b / 1024, sb = b % 1024, swz = sb ^ (((sb >> 9) & 1) << 5); R = (st >> 1) * 16 + swz / 64; C = (st & 1) * 32 + (swz % 64) / 2; }
__host__ __device__ __forceinline__ int perm32(int rho) { const int n = rho >> 4, i = rho & 15; return 8 * (i >> 2) + 4 * n + (i & 3); }

struct Unit { int pm, pn; };
struct Gemm { const bf16_t* A; const bf16_t* Bt; int M, N, K; };

struct StaticOrder {
    int nM, nN, nwg, G, c;
    __host__ __device__ void init(int M, int N, int G_, int c_) { nM = M / BM; nN = N / BM; nwg = nM * nN; G = G_; c = c_; }
    __host__ __device__ bool next(int i, Unit& u) const {
        const long L = (long)i * G + c; if (L >= nwg) return false;
        int wgid = (int)L; { const int q = nwg / NXCD, r = nwg % NXCD, xcd = wgid % NXCD, off = wgid / NXCD; wgid = (xcd < r ? xcd * (q + 1) : r * (q + 1) + (xcd - r) * q) + off; }
        const int nig = WGM * nN, gid = wgid / nig, fm = gid * WGM, gsz = (nM - fm) < WGM ? (nM - fm) : WGM;
        u.pm = fm + ((wgid % nig) % gsz); u.pn = (wgid % nig) / gsz; return true;
    }
    __device__ __forceinline__ void a_ready(const Unit&) const {}
    __device__ __forceinline__ void done(const Unit&) const {}
};
struct CountedOrder : StaticOrder {
    const unsigned* ready; unsigned need; unsigned* tmo;
    __device__ __forceinline__ void a_ready(const Unit& u) const {
        if (threadIdx.x < 64) {
            const unsigned long long t0 = __builtin_amdgcn_s_memrealtime(); unsigned polls = 0;
            while ((unsigned)__builtin_amdgcn_readfirstlane(__hip_atomic_load(ready + 64 * u.pm, __ATOMIC_RELAXED, __HIP_MEMORY_SCOPE_AGENT)) < need) {
                if ((++polls & 255u) == 0u && __builtin_amdgcn_readfirstlane(__hip_atomic_load(tmo, __ATOMIC_RELAXED, __HIP_MEMORY_SCOPE_AGENT)) != 0u) break;
                if (__builtin_amdgcn_s_memrealtime() - t0 > 2000000ull) {
                    if (threadIdx.x == 0) { unsigned expect = 0u; __hip_atomic_compare_exchange_strong(tmo + 1, &expect, 0x600u | (unsigned)(u.pm & 0xff), __ATOMIC_RELAXED, __ATOMIC_RELAXED, __HIP_MEMORY_SCOPE_AGENT); __hip_atomic_store(tmo, 1u, __ATOMIC_RELAXED, __HIP_MEMORY_SCOPE_AGENT); }
                    break; }
                __builtin_amdgcn_s_sleep(2); }
            __builtin_amdgcn_fence(__ATOMIC_ACQUIRE, "agent");
            asm volatile("s_waitcnt vmcnt(0)" ::: "memory");
        }
#if !defined(BROKEN_HOOK_NO_BARRIER)
        asm volatile("" ::: "memory"); __builtin_amdgcn_s_barrier(); asm volatile("" ::: "memory");
#endif
    }
};

__device__ __forceinline__ unsigned cvt_pk_bf16(float lo, float hi) { unsigned r; asm volatile("v_cvt_pk_bf16_f32 %0, %1, %2" : "=v"(r) : "v"(lo), "v"(hi)); return r; }
typedef float f32x2 __attribute__((ext_vector_type(2)));
__device__ __forceinline__ f32x2 gelu_pk(f32x2 v) {
    const f32x2 av = __builtin_elementwise_abs(v), d = av * 0.2316418882f + 1.0f;
    f32x2 t; t.x = __builtin_amdgcn_rcpf(d.x); t.y = __builtin_amdgcn_rcpf(d.y);
    f32x2 q = t * 0.5307027145f + (-0.7265760135f); q = q * t + 0.7107068705f; q = q * t + (-0.142248368f); q = q * t + 0.127414796f; q = q * t;
    const f32x2 s = (v * v) * (-0.72134752044f);
    f32x2 e; e.x = __builtin_amdgcn_exp2f(s.x); e.y = __builtin_amdgcn_exp2f(s.y);
    const f32x2 m = v * (q * e), r = v - m;
    f32x2 o; o.x = v.x < 0.f ? m.x : r.x; o.y = v.y < 0.f ? m.y : r.y; return o;
}

struct EpiF32 {
    static constexpr bool PERM = false, AFTER_DRAIN = false;
    float* C; int ldc; const float* bias;
    __device__ __forceinline__ void operator()(const f32x4 (&acc)[2][2][4][2], const Unit& u, int wr, int wc, int fr, int fq) const {
        const int row0 = u.pm * BM + wr * 64 + fr, col0 = u.pn * BM + wc * 32 + 4 * fq;
        f32x4 bv[2][2];
#pragma unroll
        for (int bj = 0; bj < 2; ++bj)
#pragma unroll
            for (int n = 0; n < 2; ++n) bv[bj][n] = bias ? *(const f32x4*)(bias + col0 + bj * HALF + n * 16) : (f32x4){0.f, 0.f, 0.f, 0.f};
#pragma unroll
        for (int ai = 0; ai < 2; ++ai)
#pragma unroll
            for (int m = 0; m < 4; ++m) { float* rowp = C + (size_t)(row0 + ai * HALF + m * 16) * ldc + col0;
#pragma unroll
                for (int bj = 0; bj < 2; ++bj)
#pragma unroll
                    for (int n = 0; n < 2; ++n) *(f32x4*)(rowp + bj * HALF + n * 16) = acc[ai][bj][m][n] + bv[bj][n]; }
    }
};
template <int ACT  > struct EpiBf16 {
    static constexpr bool PERM = true, AFTER_DRAIN = false;
    bf16_t* O; int ldc; const float* bias; int split_cols; size_t split_stride;
    __device__ __forceinline__ void operator()(const f32x4 (&acc)[2][2][4][2], const Unit& u, int wr, int wc, int fr, int fq) const {
        const int row0 = u.pm * BM + wr * 64 + fr; int colt = u.pn * BM; bf16_t* base = O;
        if (split_cols) { const int t = colt / split_cols; base += (size_t)t * split_stride; colt -= t * split_cols; }
        const int col0 = colt + wc * 32 + 8 * fq, bcol0 = u.pn * BM + wc * 32 + 8 * fq;
        f32x4 bv[2][2];
#pragma unroll
        for (int bj = 0; bj < 2; ++bj)
#pragma unroll
            for (int n = 0; n < 2; ++n) bv[bj][n] = bias ? *(const f32x4*)(bias + bcol0 + bj * HALF + 4 * n) : (f32x4){0.f, 0.f, 0.f, 0.f};
#pragma unroll
        for (int ai = 0; ai < 2; ++ai)
#pragma unroll
            for (int m = 0; m < 4; ++m) { bf16_t* rowp = base + (size_t)(row0 + ai * HALF + m * 16) * ldc + col0;
#pragma unroll
                for (int bj = 0; bj < 2; ++bj) { f32x4 v0 = acc[ai][bj][m][0] + bv[bj][0], v1 = acc[ai][bj][m][1] + bv[bj][1];
                    if (ACT == 1) { f32x2 a = gelu_pk((f32x2){v0[0], v0[1]}), b = gelu_pk((f32x2){v0[2], v0[3]}), c = gelu_pk((f32x2){v1[0], v1[1]}), d = gelu_pk((f32x2){v1[2], v1[3]});
                        v0 = (f32x4){a.x, a.y, b.x, b.y}; v1 = (f32x4){c.x, c.y, d.x, d.y}; }
                    if (ACT == 2) {
#pragma unroll
                        for (int j = 0; j < 4; ++j) { v0[j] = 0.5f * v0[j] * (1.0f + erff(v0[j] * 0.70710678f)); v1[j] = 0.5f * v1[j] * (1.0f + erff(v1[j] * 0.70710678f)); } }
                    u32x4 w; w.x = cvt_pk_bf16(v0[0], v0[1]); w.y = cvt_pk_bf16(v0[2], v0[3]); w.z = cvt_pk_bf16(v1[0], v1[1]); w.w = cvt_pk_bf16(v1[2], v1[3]);
                    *(u32x4*)(rowp + bj * HALF) = w; } }
    }
};

struct PanelStats {
    unsigned* xbuf;
    unsigned* cnt;
    unsigned* tmo;
    int ntn; float eps;
    unsigned code;
    __device__ __forceinline__ bool run(const f32x4 (&v)[2][2][4][2], const Unit& u, int wr, int wc, int fr, int fq, PG8_LAS unsigned char* lds, int wid, int lane) const {
        typedef float f32x2v __attribute__((ext_vector_type(2)));
        PG8_LAS f32x2v* P = (PG8_LAS f32x2v*)lds;
        PG8_LAS f32x2v* S = (PG8_LAS f32x2v*)(lds + 8192);
        PG8_LAS unsigned* flag = (PG8_LAS unsigned*)(lds + 8192 + 2048);
#pragma unroll
        for (int ai = 0; ai < 2; ++ai)
#pragma unroll
            for (int m = 0; m < 4; ++m) {
                float s = 0.f;
#pragma unroll
                for (int bj = 0; bj < 2; ++bj)
#pragma unroll
                    for (int n = 0; n < 2; ++n) { const f32x4 x = v[ai][bj][m][n]; s += (x[0] + x[1]) + (x[2] + x[3]); }
                s += __shfl_xor(s, 16); s += __shfl_xor(s, 32);
                const float mw = s * (1.0f / 64.0f); float q = 0.f;
#pragma unroll
                for (int bj = 0; bj < 2; ++bj)
#pragma unroll
                    for (int n = 0; n < 2; ++n) { const f32x4 d = v[ai][bj][m][n] - mw; q += (d[0] * d[0] + d[1] * d[1]) + (d[2] * d[2] + d[3] * d[3]); }
                q += __shfl_xor(q, 16); q += __shfl_xor(q, 32);
                if (fq == 0) P[(ai * HALF + wr * 64 + m * 16 + fr) * 4 + wc] = (f32x2v){mw, q};
            }
        asm volatile("s_waitcnt lgkmcnt(0)" ::: "memory"); __builtin_amdgcn_s_barrier(); asm volatile("" ::: "memory");
#if defined(BROKEN_NO_WAIT)
        if (blockIdx.x >= 64) { const long long t0 = clock64(); while (clock64() - t0 < 60000) __builtin_amdgcn_s_sleep(8); }
#endif
        const int row = wid * 32 + (lane & 31);
        if (lane < 32) {
            const f32x2v a = P[row * 4 + 0], b = P[row * 4 + 1], c = P[row * 4 + 2], d = P[row * 4 + 3];
            const float mt = (a.x + b.x + c.x + d.x) * 0.25f;
            const float da = a.x - mt, db = b.x - mt, dc = c.x - mt, dd = d.x - mt;
            const float m2 = (a.y + b.y) + (c.y + d.y) + 64.0f * ((da * da + db * db) + (dc * dc + dd * dd));
            unsigned long long* slot = (unsigned long long*)xbuf + ((size_t)(u.pm * BM + row) * 4 + u.pn);
            __hip_atomic_store(slot, ((unsigned long long)__float_as_uint(m2) << 32) | __float_as_uint(mt), __ATOMIC_RELAXED, __HIP_MEMORY_SCOPE_AGENT);
        }
        asm volatile("s_waitcnt vmcnt(0)" ::: "memory");
        if (lane == 0) __hip_atomic_fetch_add(cnt + 64 * u.pm, 1u, __ATOMIC_RELAXED, __HIP_MEMORY_SCOPE_AGENT);
        if (wid == 0) {
            bool dead = false; const unsigned long long t0 = __builtin_amdgcn_s_memrealtime(); const unsigned want = 8u * (unsigned)ntn;
            for (;;) {
#if defined(BROKEN_NO_WAIT)
                break;
#endif
                if ((unsigned)__builtin_amdgcn_readfirstlane(__hip_atomic_load(cnt + 64 * u.pm, __ATOMIC_RELAXED, __HIP_MEMORY_SCOPE_AGENT)) >= want) break;
                if (__builtin_amdgcn_s_memrealtime() - t0 > 2000000ull) {
                    if (lane == 0) { unsigned expect = 0u; __hip_atomic_compare_exchange_strong(tmo + 1, &expect, code | (unsigned)(u.pm & 0xff), __ATOMIC_RELAXED, __ATOMIC_RELAXED, __HIP_MEMORY_SCOPE_AGENT);
                                     __hip_atomic_store(tmo, 1u, __ATOMIC_RELAXED, __HIP_MEMORY_SCOPE_AGENT); }
                    dead = true; break; }
                __builtin_amdgcn_s_sleep(2);
            }
            __builtin_amdgcn_fence(__ATOMIC_ACQUIRE, "agent");
            if (lane == 0) flag[0] = dead ? 1u : 0u;
        }
        asm volatile("s_waitcnt vmcnt(0) lgkmcnt(0)" ::: "memory"); __builtin_amdgcn_s_barrier(); asm volatile("" ::: "memory");
        const bool bad = flag[0] != 0u;
        if (lane < 32) {
            const unsigned long long* slot = (const unsigned long long*)xbuf + (size_t)(u.pm * BM + row) * 4; float mt[4], m2[4]; float ms = 0.f;
#pragma unroll
            for (int t = 0; t < 4; ++t) { if (t < ntn) { const unsigned long long w = __hip_atomic_load(slot + t, __ATOMIC_RELAXED, __HIP_MEMORY_SCOPE_AGENT); mt[t] = __uint_as_float((unsigned)w); m2[t] = __uint_as_float((unsigned)(w >> 32)); } else { mt[t] = 0.f; m2[t] = 0.f; } ms += mt[t]; }
            const float mean = ms / (float)ntn; float q = 0.f;
#pragma unroll
            for (int t = 0; t < 4; ++t) if (t < ntn) { const float dm = mt[t] - mean; q += m2[t] + 256.0f * dm * dm; }
            S[row] = (f32x2v){mean, 1.0f / sqrtf(q / (256.0f * (float)ntn) + eps)};
        }
        asm volatile("s_waitcnt lgkmcnt(0)" ::: "memory"); __builtin_amdgcn_s_barrier(); asm volatile("" ::: "memory");
        return bad;
    }
};
struct EpiLnRes {
    static constexpr bool PERM = false, AFTER_DRAIN = true;
    const float* base; float* out; int ldc; const float* bias; PanelStats st; unsigned poison;
    __device__ __forceinline__ void refuse(size_t i0, size_t stride, int M, int N) const { const float q = __builtin_nanf(""); for (size_t i = i0; i < (size_t)M * N; i += stride) out[(i / N) * ldc + i % N] = q;
        if (i0 == 0) { unsigned expect = 0u; __hip_atomic_compare_exchange_strong(st.tmo + 1, &expect, 0x7f0u, __ATOMIC_RELAXED, __ATOMIC_RELAXED, __HIP_MEMORY_SCOPE_AGENT); __hip_atomic_store(st.tmo, 1u, __ATOMIC_RELAXED, __HIP_MEMORY_SCOPE_AGENT); } }
    __device__ __forceinline__ void fused(f32x4 (&acc)[2][2][4][2], const Unit& u, int wr, int wc, int fr, int fq, PG8_LAS unsigned char* lds, int wid, int lane) const {
        typedef float f32x2v __attribute__((ext_vector_type(2)));
        const PG8_LAS f32x2v* S = (const PG8_LAS f32x2v*)(lds + 8192);
        const int col0 = u.pn * BM + wc * 32 + 4 * fq;
#pragma unroll
        for (int bj = 0; bj < 2; ++bj)
#pragma unroll
            for (int n = 0; n < 2; ++n) { const f32x4 bv = bias ? *(const f32x4*)(bias + col0 + bj * HALF + n * 16) : (f32x4){0.f, 0.f, 0.f, 0.f};
#pragma unroll
                for (int ai = 0; ai < 2; ++ai)
#pragma unroll
                    for (int m = 0; m < 4; ++m) acc[ai][bj][m][n] += bv; }
        const bool bad = st.run(acc, u, wr, wc, fr, fq, lds, wid, lane) || poison != 0u;
        const float qnan = __builtin_nanf("");
#pragma unroll
        for (int ai = 0; ai < 2; ++ai)
#pragma unroll
            for (int m = 0; m < 4; ++m) { const int r = ai * HALF + wr * 64 + m * 16 + fr; const f32x2v sr = S[r]; const size_t off = (size_t)(u.pm * BM + r) * ldc + col0;
#pragma unroll
                for (int bj = 0; bj < 2; ++bj)
#pragma unroll
                    for (int n = 0; n < 2; ++n) { const f32x4 bs = *(const f32x4*)(base + off + bj * HALF + n * 16); f32x4 o = bs + (acc[ai][bj][m][n] - sr.x) * sr.y;
                        if (bad) o = (f32x4){qnan, qnan, qnan, qnan}; *(f32x4*)(out + off + bj * HALF + n * 16) = o; }
                asm volatile("" ::: "memory"); }
    }
};
struct EpiLnResLn {
    static constexpr bool PERM = false, AFTER_DRAIN = true;
    const float* base; float* out; bf16_t* xn; int ldc; const float* bias; PanelStats st1, st2; unsigned poison;
    __device__ __forceinline__ void refuse(size_t i0, size_t stride, int M, int N) const { const float q = __builtin_nanf(""); for (size_t i = i0; i < (size_t)M * N; i += stride) { const size_t o = (i / N) * ldc + i % N; out[o] = q; xn[o] = (bf16_t)0x7fc0u; }
        if (i0 == 0) { unsigned expect = 0u; __hip_atomic_compare_exchange_strong(st1.tmo + 1, &expect, 0x7f0u, __ATOMIC_RELAXED, __ATOMIC_RELAXED, __HIP_MEMORY_SCOPE_AGENT); __hip_atomic_store(st1.tmo, 1u, __ATOMIC_RELAXED, __HIP_MEMORY_SCOPE_AGENT); } }
    __device__ __forceinline__ void fused(f32x4 (&acc)[2][2][4][2], const Unit& u, int wr, int wc, int fr, int fq, PG8_LAS unsigned char* lds, int wid, int lane) const {
        typedef float f32x2v __attribute__((ext_vector_type(2))); typedef unsigned u32x2v __attribute__((ext_vector_type(2)));
        const PG8_LAS f32x2v* S = (const PG8_LAS f32x2v*)(lds + 8192);
        const int col0 = u.pn * BM + wc * 32 + 4 * fq;
#pragma unroll
        for (int bj = 0; bj < 2; ++bj)
#pragma unroll
            for (int n = 0; n < 2; ++n) { const f32x4 bv = bias ? *(const f32x4*)(bias + col0 + bj * HALF + n * 16) : (f32x4){0.f, 0.f, 0.f, 0.f};
#pragma unroll
                for (int ai = 0; ai < 2; ++ai)
#pragma unroll
                    for (int m = 0; m < 4; ++m) acc[ai][bj][m][n] += bv; }
        bool bad = st1.run(acc, u, wr, wc, fr, fq, lds, wid, lane) || poison != 0u;
        const float qnan = __builtin_nanf("");
#pragma unroll
        for (int ai = 0; ai < 2; ++ai)
#pragma unroll
            for (int m = 0; m < 4; ++m) { const int r = ai * HALF + wr * 64 + m * 16 + fr; const f32x2v sr = S[r]; const size_t off = (size_t)(u.pm * BM + r) * ldc + col0;
#pragma unroll
                for (int bj = 0; bj < 2; ++bj)
#pragma unroll
                    for (int n = 0; n < 2; ++n) { const f32x4 bs = *(const f32x4*)(base + off + bj * HALF + n * 16); acc[ai][bj][m][n] = bs + (acc[ai][bj][m][n] - sr.x) * sr.y; }
                asm volatile("" : "+v"(acc[ai][0][m][0]), "+v"(acc[ai][0][m][1]), "+v"(acc[ai][1][m][0]), "+v"(acc[ai][1][m][1]));
                if (m & 1) asm volatile("" ::: "memory"); }
        const bool bad1 = bad;
        bad = st2.run(acc, u, wr, wc, fr, fq, lds, wid, lane) || bad;
#pragma unroll
        for (int ai = 0; ai < 2; ++ai)
#pragma unroll
            for (int m = 0; m < 4; ++m) { const int r = ai * HALF + wr * 64 + m * 16 + fr; const f32x2v sr = S[r]; const size_t off = (size_t)(u.pm * BM + r) * ldc + col0;
#pragma unroll
                for (int bj = 0; bj < 2; ++bj)
#pragma unroll
                    for (int n = 0; n < 2; ++n) { const f32x4 x1 = acc[ai][bj][m][n]; *(f32x4*)(out + off + bj * HALF + n * 16) = bad1 ? (f32x4){qnan, qnan, qnan, qnan} : x1;
                        const f32x4 o = (x1 - sr.x) * sr.y; u32x2v w; w.x = cvt_pk_bf16(o[0], o[1]); w.y = cvt_pk_bf16(o[2], o[3]);
                        if (bad) { w.x = 0x7fc07fc0u; w.y = 0x7fc07fc0u; } *(u32x2v*)(xn + off + bj * HALF + n * 16) = w; }
                asm volatile("" ::: "memory"); }
    }
};

template <class Epi, class Sched, bool STAMP = false>
__device__ __forceinline__ void gemm_phase(PG8_LAS unsigned char* lds, const Gemm g, const Sched& S, const Epi& E, unsigned long long* stamps) {
    const int tid = threadIdx.x, wid = __builtin_amdgcn_readfirstlane(tid >> 6), lane = tid & 63, wr = wid >> 2, wc = wid & 3, fr = lane & 15, fq = lane >> 4;
    const int K = g.K, nt = K / BK;
    int ts_lo = 0, ts_hi = 0, nts = 0; const unsigned long long rt_entry = STAMP ? (unsigned long long)wall_clock64() : 0ull;
#define PG8_STAMP() do { if (STAMP && wid == 0 && nts < 64) { const unsigned long long _c = (unsigned long long)clock64(); \
        ts_lo = (lane == nts) ? (int)(unsigned)_c : ts_lo; ts_hi = (lane == nts) ? (int)(unsigned)(_c >> 32) : ts_hi; ++nts; } } while (0)
    PG8_STAMP();
    unsigned voffA[2], voffB[2];
#pragma unroll
    for (int i = 0; i < 2; ++i) { int R, C; stage_rc(tid * 16 + i * 8192, R, C); const int Rb = Epi::PERM ? ((R & ~31) + perm32(R & 31)) : R;
        voffA[i] = (unsigned)(R * K + C) * 2u; voffB[i] = (unsigned)(Rb * K + C) * 2u; }
    const size_t kstep = (size_t)(BK * 2);
    const size_t hstep = (size_t)HALF * K * 2;
    const size_t tstep = 2 * hstep;
    const unsigned ldsw = (unsigned)wid * 1024u;
    const int aoff = lds_byte(wr * 64 + fr, fq * 8), boff = lds_byte(wc * 32 + fr, fq * 8);
#define PG8_SA(b, h) (((b) * 2 + (h)) * HTB)
#define PG8_SB(b, h) ((4 + (b) * 2 + (h)) * HTB)
#define PG8_STAGE(bufoff, gbase, voff) do { _Pragma("unroll") for (int _i = 0; _i < 2; ++_i) \
        __builtin_amdgcn_global_load_lds((const unsigned*)((const char*)(gbase) + (voff)[_i]), (PG8_LAS unsigned*)(lds + (bufoff) + ldsw + _i * 8192), 16, 0, 0); } while (0)
#define PG8_LDA(dst, b, h) do { _Pragma("unroll") for (int m = 0; m < 4; ++m) _Pragma("unroll") for (int k = 0; k < 2; ++k) dst[m][k] = *(const PG8_LAS bf16x8*)(lds + PG8_SA(b, h) + aoff + m * 2048 + k * 1024); } while (0)
#define PG8_LDB(dst, b, h) do { _Pragma("unroll") for (int n = 0; n < 2; ++n) _Pragma("unroll") for (int k = 0; k < 2; ++k) dst[n][k] = *(const PG8_LAS bf16x8*)(lds + PG8_SB(b, h) + boff + n * 2048 + k * 1024); } while (0)
#define PG8_MMA(ai, bj, At, Bt) do { __builtin_amdgcn_s_setprio(1); _Pragma("unroll") for (int m = 0; m < 4; ++m) _Pragma("unroll") for (int n = 0; n < 2; ++n) _Pragma("unroll") for (int k = 0; k < 2; ++k) \
        acc[ai][bj][m][n] = __builtin_amdgcn_mfma_f32_16x16x32_bf16(Bt[n][k], At[m][k], acc[ai][bj][m][n], 0, 0, 0); __builtin_amdgcn_s_setprio(0); } while (0)
#define PG8_WAIT_V(n) asm volatile("s_waitcnt vmcnt(" #n ")" ::: "memory")
#define PG8_WAIT_L(n) asm volatile("s_waitcnt lgkmcnt(" #n ")" ::: "memory")
#define PG8_BAR __builtin_amdgcn_s_barrier()
#define PG8_SCHED __builtin_amdgcn_sched_barrier(0)
    Unit cur, nxt; int ui = 0;
    if (!S.next(0, cur)) return;
    f32x4 acc[2][2][4][2];
#pragma unroll
    for (int a = 0; a < 2; ++a)
#pragma unroll
        for (int b = 0; b < 2; ++b)
#pragma unroll
            for (int m = 0; m < 4; ++m)
#pragma unroll
                for (int n = 0; n < 2; ++n) acc[a][b][m][n] = (f32x4){0.f, 0.f, 0.f, 0.f};
    bf16x8 At[4][2], B0[2][2], B1[2][2];
    const char* cA = (const char*)g.A + (size_t)cur.pm * tstep; const char* cB = (const char*)g.Bt + (size_t)cur.pn * tstep;
    S.a_ready(cur);
    PG8_STAGE(PG8_SB(0, 0), cB, voffB); PG8_STAGE(PG8_SA(0, 0), cA, voffA); PG8_STAGE(PG8_SB(0, 1), cB + hstep, voffB); PG8_STAGE(PG8_SA(0, 1), cA + hstep, voffA);
    if (wr == 1) PG8_BAR;
    PG8_WAIT_V(4); PG8_BAR;
    PG8_STAGE(PG8_SB(1, 0), cB + kstep, voffB); PG8_STAGE(PG8_SA(1, 0), cA + kstep, voffA); PG8_STAGE(PG8_SB(1, 1), cB + hstep + kstep, voffB);
    PG8_WAIT_V(6); PG8_BAR;
    PG8_STAMP();
    for (;;) {
        const bool has_next = S.next(ui + 1, nxt);
        const char* nA = has_next ? (const char*)g.A + (size_t)nxt.pm * tstep : cA; const char* nB = has_next ? (const char*)g.Bt + (size_t)nxt.pn * tstep : cB;
        for (int t = 0; t < nt; t += 2) {
            const bool last = (t == nt - 2);
            const char* a1 = cA + (size_t)(t + 1) * kstep;
            const char* a2 = last ? nA : cA + (size_t)(t + 2) * kstep; const char* b2 = last ? nB : cB + (size_t)(t + 2) * kstep;
            const char* a3 = a2 + kstep; const char* b3 = b2 + kstep;
            if (last && has_next) S.a_ready(nxt);
            PG8_LDB(B0, 0, 0); PG8_SCHED; PG8_LDA(At, 0, 0); PG8_STAGE(PG8_SA(1, 1), a1 + hstep, voffA);
            PG8_WAIT_L(8); PG8_BAR; PG8_WAIT_L(0); PG8_MMA(0, 0, At, B0); PG8_BAR; PG8_SCHED;
            PG8_LDB(B1, 0, 1); PG8_STAGE(PG8_SB(0, 0), b2, voffB);
            PG8_BAR; PG8_WAIT_L(0); PG8_MMA(0, 1, At, B1); PG8_BAR;
            PG8_LDA(At, 0, 1); PG8_STAGE(PG8_SA(0, 0), a2, voffA);
            PG8_BAR; PG8_WAIT_L(0); PG8_MMA(1, 0, At, B0); PG8_BAR; PG8_SCHED;
            PG8_STAGE(PG8_SB(0, 1), b2 + hstep, voffB);
            PG8_WAIT_V(6); PG8_BAR; PG8_MMA(1, 1, At, B1); PG8_BAR;
            PG8_LDB(B0, 1, 0); PG8_SCHED; PG8_LDA(At, 1, 0); PG8_STAGE(PG8_SA(0, 1), a2 + hstep, voffA);
            PG8_WAIT_L(8); PG8_BAR; PG8_WAIT_L(0); PG8_MMA(0, 0, At, B0); PG8_BAR; PG8_SCHED;
            PG8_LDB(B1, 1, 1); PG8_STAGE(PG8_SB(1, 0), b3, voffB);
            PG8_BAR; PG8_WAIT_L(0); PG8_MMA(0, 1, At, B1); PG8_BAR;
            PG8_LDA(At, 1, 1); PG8_STAGE(PG8_SA(1, 0), a3, voffA);
            PG8_BAR; PG8_WAIT_L(0); PG8_MMA(1, 0, At, B0); PG8_BAR; PG8_SCHED;
            PG8_STAGE(PG8_SB(1, 1), b3 + hstep, voffB);
            PG8_WAIT_V(6); PG8_BAR; PG8_MMA(1, 1, At, B1); PG8_BAR;
        }
        PG8_STAMP();
        if constexpr (!Epi::AFTER_DRAIN) { E(acc, cur, wr, wc, fr, fq); S.done(cur); }
        PG8_STAMP();
        if (!has_next) break;
#pragma unroll
        for (int a = 0; a < 2; ++a)
#pragma unroll
            for (int b = 0; b < 2; ++b)
#pragma unroll
                for (int m = 0; m < 4; ++m)
#pragma unroll
                    for (int n = 0; n < 2; ++n) acc[a][b][m][n] = (f32x4){0.f, 0.f, 0.f, 0.f};
        cur = nxt; cA = nA; cB = nB; ++ui;
    }
    PG8_WAIT_V(0);
    if (wr == 0) PG8_BAR;
    PG8_BAR;
    if constexpr (Epi::AFTER_DRAIN) { E.fused(acc, cur, wr, wc, fr, fq, lds, wid, lane); S.done(cur); }
    PG8_STAMP();
    if (STAMP && wid == 0) { stamps[lane] = lane < nts ? (((unsigned long long)(unsigned)ts_hi << 32) | (unsigned)ts_lo) : 0ull;
        if (lane == 62) stamps[62] = rt_entry; if (lane == 63) stamps[63] = (unsigned long long)wall_clock64(); }
#undef PG8_STAMP
#undef PG8_SA
#undef PG8_SB
#undef PG8_STAGE
#undef PG8_LDA
#undef PG8_LDB
#undef PG8_MMA
#undef PG8_WAIT_V
#undef PG8_WAIT_L
#undef PG8_BAR
#undef PG8_SCHED
}
}

namespace cg = cooperative_groups;
#define LAS __attribute__((address_space(3)))
typedef unsigned short bf16_t;
typedef short bf16x8 __attribute__((ext_vector_type(8)));
typedef short s16x4 __attribute__((ext_vector_type(4)));
typedef float f32x4 __attribute__((ext_vector_type(4)));
typedef float f32x16 __attribute__((ext_vector_type(16)));
typedef unsigned u32x4 __attribute__((ext_vector_type(4)));
typedef unsigned u32x2 __attribute__((ext_vector_type(2)));

constexpr int DM = 2048, M_CTX = 4096, M_ALL = 12288, NIN = 9216;
constexpr float EPS = 1e-6f;
constexpr size_t SLOT = (size_t)M_ALL * 1024 * 2;
constexpr size_t WS_PROJ = 0;
constexpr size_t WS_WINT = 9 * SLOT;
constexpr size_t WS_WOUTT = 11 * SLOT;
constexpr size_t WS_PART = WS_WOUTT + (size_t)2048 * 2048 * 2;
constexpr size_t WS_GATE = WS_PART + (size_t)16 * 3 * 6144 * 4;
constexpr size_t WS_EVEC = WS_GATE + 3 * 2048 * 4;
constexpr size_t WS_ROPE = WS_EVEC + (size_t)192 * 8 * 2 * 128 * 4;
constexpr size_t WS_LB = WS_ROPE + 64 * 32 * 2 * 4;
constexpr size_t WS_LG = WS_LB + 2 * 1024 * 4;
constexpr size_t WS_END = WS_LG + 256;
constexpr size_t WS_OMIX = 4 * SLOT;
constexpr size_t WS_XS = 0;
constexpr int LDS_BYTES = 147456;

struct Args { const float* in[17]; float* out; unsigned char* ws; };

__device__ __forceinline__ unsigned cvtpk(float lo, float hi) { unsigned r; asm volatile("v_cvt_pk_bf16_f32 %0, %1, %2" : "=v"(r) : "v"(lo), "v"(hi)); return r; }
__device__ __forceinline__ float bflo(unsigned u) { return __builtin_bit_cast(float, u << 16); }
__device__ __forceinline__ float bfhi(unsigned u) { return __builtin_bit_cast(float, u & 0xffff0000u); }
__device__ __forceinline__ float bf2f(bf16_t b) { return __builtin_bit_cast(float, (unsigned)b << 16); }
__device__ __forceinline__ float wave_sum(float v) {
#pragma unroll
    for (int o = 1; o < 64; o <<= 1) v += __shfl_xor(v, o);
    return v;
}
#define LDS_WAIT() asm volatile("s_waitcnt lgkmcnt(0)" ::: "memory")
#define MFMA32(a, b, c) __builtin_amdgcn_mfma_f32_32x32x16_bf16((a), (b), (c), 0, 0, 0)

__device__ __forceinline__ void p0_transpose_item(const float* W, int K, int N, bf16_t* WT, LAS float* scr, int item, int lane, int sc_lo, int sc_hi, float scale) {
    const int nblk = N / 32, kb = item / nblk, nb = item % nblk, k0 = 64 * kb, n0 = 32 * nb;
    const float sc = (n0 >= sc_lo && n0 < sc_hi) ? scale : 1.0f;
#pragma unroll 8
    for (int i = 0; i < 32; ++i) { const int kk = 2 * i + (lane >> 5); scr[kk * 33 + (lane & 31)] = W[(size_t)(k0 + kk) * N + n0 + (lane & 31)] * sc; }
    LDS_WAIT();
    const int c = lane & 7;
#pragma unroll
    for (int j = 0; j < 4; ++j) { const int n = (lane >> 3) + 8 * j; const LAS float* s = scr + (8 * c) * 33 + n;
        u32x4 o; o.x = cvtpk(s[0 * 33], s[1 * 33]); o.y = cvtpk(s[2 * 33], s[3 * 33]); o.z = cvtpk(s[4 * 33], s[5 * 33]); o.w = cvtpk(s[6 * 33], s[7 * 33]);
        *(u32x4*)(WT + (size_t)(n0 + n) * K + k0 + 8 * c) = o; }
    LDS_WAIT();
}
__device__ __forceinline__ void p0_gemv_task(const Args& a, int task, LAS float* scr, int lane) {
    const int cgp = task % 24, ks = task / 24;
#pragma unroll
    for (int m = 0; m < 3; ++m)
#pragma unroll
        for (int hf = 0; hf < 2; ++hf) { const int k = 128 * ks + 64 * hf + lane; const float c = (m == 0) ? a.in[7][k] : a.in[6][(m - 1) * 2048 + k];
            scr[m * 128 + 64 * hf + lane] = c / (1.0f + __expf(-c)); }
    LDS_WAIT();
    const float* w = a.in[9] + (size_t)(128 * ks) * 6144 + 256 * cgp + 4 * lane;
    f32x4 a0 = {0.f, 0.f, 0.f, 0.f}, a1 = a0, a2 = a0;
#pragma unroll 16
    for (int kk = 0; kk < 128; ++kk) { const f32x4 wv = *(const f32x4*)(w + (size_t)kk * 6144); a0 += scr[kk] * wv; a1 += scr[128 + kk] * wv; a2 += scr[256 + kk] * wv; }
    float* part = (float*)(a.ws + WS_PART) + (size_t)(ks * 3) * 6144 + 256 * cgp + 4 * lane;
    *(f32x4*)(part) = a0; *(f32x4*)(part + 6144) = a1; *(f32x4*)(part + 2 * 6144) = a2;
    LDS_WAIT();
}
__device__ __forceinline__ void phase0(const Args& a, LAS unsigned char* lds) {
    const int tid = threadIdx.x, lane = tid & 63, wave = tid >> 6;
    LAS float* scr = (LAS float*)(lds + wave * 16384);
    const int gw = blockIdx.x * 8 + wave, NGW = gridDim.x * 8;
    constexpr int T_GEMV = 24 * 16, T_WIN = 32 * (NIN / 32), T_WOUT = 32 * (2048 / 32);
    for (int t = gw; t < T_GEMV + T_WIN + T_WOUT; t += NGW) {
        if (t < T_GEMV) p0_gemv_task(a, t, scr, lane);
        else if (t < T_GEMV + T_WIN) p0_transpose_item(a.in[11], 2048, NIN, (bf16_t*)(a.ws + WS_WINT), scr, t - T_GEMV, lane, 1024, 2048, 0.08838834764831845f);
        else p0_transpose_item(a.in[15], 2048, 2048, (bf16_t*)(a.ws + WS_WOUTT), scr, t - T_GEMV - T_WIN, lane, 0, 0, 1.0f);
    }
    const int gt = blockIdx.x * 512 + tid;
    if (gt < 2048) { const int pos = gt >> 5, f = gt & 31; const float fr = powf(10000.0f, -(float)f / 32.0f); const float ang = (float)pos * fr;
        float* r = (float*)(a.ws + WS_ROPE); r[2 * gt] = cosf(ang); r[2 * gt + 1] = sinf(ang); }
    else if (gt < 4096) { const int i = gt - 2048, dir = i >> 10, col = i & 1023; const float x0 = a.in[13][dir * 2048 + col], x1 = a.in[13][dir * 2048 + 1024 + col];
        ((float*)(a.ws + WS_LB))[i] = 1.0f / (1.0f + expf(x1 - x0)); }
    else if (gt < 4096 + 16) { const int i = gt - 4096; ((float*)(a.ws + WS_LG))[i] = log1pf(-expf(a.in[12][i])); }
}

__device__ __forceinline__ void phase1(const Args& a, LAS unsigned char* lds) {
    const int tid = threadIdx.x, lane = tid & 63, wave = tid >> 6;
    LAS float* AT = (LAS float*)lds;
    LAS float* ST = (LAS float*)(lds + 24576);
    const float* part = (const float*)(a.ws + WS_PART);
    for (int idx = tid; idx < 3 * 4096; idx += 512) { const int m = idx >> 12, c = idx & 4095; float s = a.in[10][c];
#pragma unroll
        for (int ks = 0; ks < 16; ++ks) s += part[(size_t)(ks * 3 + m) * 6144 + c];
        if (c < 2048) ST[m * 2048 + c] = s; else AT[m * 2048 + c - 2048] = a.in[8][c - 2048] * (1.0f + s); }
    if (blockIdx.x == 0) for (int idx = tid; idx < 3 * 2048; idx += 512) { const int m = idx >> 11, c = idx & 2047; float s = a.in[10][4096 + c];
#pragma unroll
        for (int ks = 0; ks < 16; ++ks) s += part[(size_t)(ks * 3 + m) * 6144 + 4096 + c];
        ((float*)(a.ws + WS_GATE))[idx] = s; }
    __syncthreads();
    bf16_t* H = (bf16_t*)a.out;
    const int gw = blockIdx.x * 8 + wave, NGW = gridDim.x * 8;
    for (int row = gw; row < M_ALL; row += NGW) {
        const float* xr = row < M_CTX ? a.in[0] + (size_t)row * DM : a.in[1] + (size_t)(row - M_CTX) * DM;
        const int m = row < M_CTX ? 0 : 1 + ((row - M_CTX) >> 12);
        f32x4 v[8]; float ss = 0.f;
#pragma unroll
        for (int j = 0; j < 8; ++j) { v[j] = *(const f32x4*)(xr + 4 * lane + 256 * j); ss += (v[j].x * v[j].x + v[j].y * v[j].y) + (v[j].z * v[j].z + v[j].w * v[j].w); }
        const float rstd = 1.0f / sqrtf(wave_sum(ss) * (1.0f / DM) + EPS);
#pragma unroll
        for (int j = 0; j < 8; ++j) { const f32x4 av = *(const LAS f32x4*)(AT + m * 2048 + 4 * lane + 256 * j), sv = *(const LAS f32x4*)(ST + m * 2048 + 4 * lane + 256 * j);
            const f32x4 hv = v[j] * rstd * av + sv; u32x2 o; o.x = cvtpk(hv.x, hv.y); o.y = cvtpk(hv.z, hv.w);
            *(u32x2*)(H + (size_t)row * DM + 4 * lane + 256 * j) = o; }
    }
}

__device__ __forceinline__ bf16_t* slotp(const Args& a, int s) { return (bf16_t*)(a.ws + WS_PROJ + (size_t)s * SLOT); }
__device__ __forceinline__ void phase3(const Args& a) {
    const int tid = threadIdx.x;
    {
        const int sub = tid >> 8, dir = (tid >> 7) & 1, d = tid & 127;
        const float* LB = (const float*)(a.ws + WS_LB); float* EV = (float*)(a.ws + WS_EVEC);
        for (int p = blockIdx.x; p < 768; p += gridDim.x) {
            const int h = 2 * (p & 3) + sub, cgi = p >> 2, col = h * 128 + d; const size_t base = (size_t)cgi * 64 * 1024 + col;
            const bf16_t* q = slotp(a, 4) + base; bf16_t* zk = slotp(a, 5 + dir) + base; bf16_t* qo = slotp(a, 9 + dir) + base;
            const float lb = LB[dir * 1024 + col]; float b = 0.f;
            for (int i0 = 0; i0 < 64; i0 += 8) {
                float zz[8], qq[8];
#pragma unroll
                for (int u = 0; u < 8; ++u) { const int r = dir ? 63 - (i0 + u) : (i0 + u); zz[u] = bf2f(zk[(size_t)r * 1024]); qq[u] = bf2f(q[(size_t)r * 1024]); }
#pragma unroll
                for (int u = 0; u < 8; ++u) { const int r = dir ? 63 - (i0 + u) : (i0 + u);
                    const float sg = 1.0f / (1.0f + __expf(-zz[u])); const float f = lb + (1.0f - lb) * sg; b += __logf(f);
                    const float eb = __expf(b), ieb = __expf(-b);
                    qo[(size_t)r * 1024] = (bf16_t)(cvtpk(qq[u] * eb, 0.f) & 0xffffu); zk[(size_t)r * 1024] = (bf16_t)(cvtpk((1.0f - f) * ieb, 0.f) & 0xffffu); }
            }
            EV[((size_t)(cgi * 8 + h) * 2 + dir) * 128 + d] = __expf(b);
        }
    }
    {
        const float* RT = (const float*)(a.ws + WS_ROPE);
        const int NT = gridDim.x * 512;
        for (int idx = blockIdx.x * 512 + tid; idx < 8192 * 2 * 8 * 8; idx += NT) {
            const int jg = idx & 3, part = (idx >> 2) & 1, h = (idx >> 3) & 7, slot = (idx >> 6) & 1, r = idx >> 7, t = r & 4095;
            const int pos = part ? (t & 63) : (t >> 6);
            bf16_t* bp = slotp(a, slot) + (size_t)(M_CTX + r) * 1024 + h * 128 + part * 64 + jg * 8;
            const u32x4 x1 = *(const u32x4*)bp, x2 = *(const u32x4*)(bp + 32);
            const float* cs = RT + (size_t)(pos * 32 + jg * 8) * 2;
            u32x4 o1, o2;
#pragma unroll
            for (int e = 0; e < 4; ++e) { const f32x4 c4 = *(const f32x4*)(cs + 4 * e);
                const float a0 = bflo(x1[e]), a1 = bfhi(x1[e]), b0 = bflo(x2[e]), b1 = bfhi(x2[e]);
                o1[e] = cvtpk(a0 * c4.x - b0 * c4.y, a1 * c4.z - b1 * c4.w); o2[e] = cvtpk(a0 * c4.y + b0 * c4.x, a1 * c4.w + b1 * c4.z); }
            *(u32x4*)bp = o1; *(u32x4*)(bp + 32) = o2;
        }
    }
}

__device__ __forceinline__ unsigned off_b(unsigned row, unsigned ch) { return 256u * row + 16u * (ch ^ (((row & 3) << 2) | ((row >> 2) & 3))); }
__device__ __forceinline__ unsigned tr_addr(unsigned lane, unsigned c, unsigned ks, unsigned t) {
    const unsigned h = lane >> 5, blk = (lane >> 4) & 1, q = (lane & 15) >> 2, p = lane & 3;
    return off_b(16 * ks + 8 * h + 4 * t + q, 4 * c + 2 * blk + (p >> 1)) + 8 * (p & 1);
}
__device__ __forceinline__ unsigned pt_off(unsigned i, unsigned ch) { return 128u * i + 16u * (ch ^ ((i >> 1) & 7)); }
__device__ __forceinline__ void tr_frag4(unsigned base, unsigned lane, unsigned c, bf16x8 (&f)[4]) {
    s16x4 r0, r1, r2, r3, r4, r5, r6, r7;
    const unsigned a0 = base + tr_addr(lane, c, 0, 0), a1 = base + tr_addr(lane, c, 0, 1), a2 = base + tr_addr(lane, c, 1, 0), a3 = base + tr_addr(lane, c, 1, 1);
    const unsigned a4 = base + tr_addr(lane, c, 2, 0), a5 = base + tr_addr(lane, c, 2, 1), a6 = base + tr_addr(lane, c, 3, 0), a7 = base + tr_addr(lane, c, 3, 1);
    asm volatile("ds_read_b64_tr_b16 %0, %8\n\tds_read_b64_tr_b16 %1, %9\n\tds_read_b64_tr_b16 %2, %10\n\tds_read_b64_tr_b16 %3, %11\n\t"
                 "ds_read_b64_tr_b16 %4, %12\n\tds_read_b64_tr_b16 %5, %13\n\tds_read_b64_tr_b16 %6, %14\n\tds_read_b64_tr_b16 %7, %15\n\ts_waitcnt lgkmcnt(0)"
                 : "=&v"(r0), "=&v"(r1), "=&v"(r2), "=&v"(r3), "=&v"(r4), "=&v"(r5), "=&v"(r6), "=&v"(r7)
                 : "v"(a0), "v"(a1), "v"(a2), "v"(a3), "v"(a4), "v"(a5), "v"(a6), "v"(a7) : "memory");
    f[0] = __builtin_shufflevector(r0, r1, 0, 1, 2, 3, 4, 5, 6, 7); f[1] = __builtin_shufflevector(r2, r3, 0, 1, 2, 3, 4, 5, 6, 7);
    f[2] = __builtin_shufflevector(r4, r5, 0, 1, 2, 3, 4, 5, 6, 7); f[3] = __builtin_shufflevector(r6, r7, 0, 1, 2, 3, 4, 5, 6, 7);
}
__device__ __forceinline__ u32x4 scale_bf8(u32x4 x, float f) {
    u32x4 o;
#pragma unroll
    for (int e = 0; e < 4; ++e) o[e] = cvtpk(bflo(x[e]) * f, bfhi(x[e]) * f);
    return o;
}

constexpr unsigned L_QT = 0, L_KT = 16384, L_VT = 32768, L_SI = 49152, L_PT = 81920, L_EV = 90112;

__device__ __forceinline__ void chain_item(const Args& a, LAS unsigned char* lds, int grp, int b, int h, int type, int dir) {
    const int tid = threadIdx.x, lane = tid & 63, w = __builtin_amdgcn_readfirstlane(tid >> 6), r = lane & 31, hh = lane >> 5;
    const unsigned lbase = (unsigned)(size_t)lds;
    const int nch = grp ? 64 : 4, rowbase = grp ? M_CTX + b * 4096 : b * 256;
    const bf16_t* qs = type ? slotp(a, 9 + dir) : slotp(a, 0);
    const bf16_t* ks_ = type ? slotp(a, 5 + dir) : slotp(a, 1);
    const bf16_t* vs = type ? slotp(a, 7) : slotp(a, 2);
    const float* EVg = (const float*)(a.ws + WS_EVEC);
    bf16_t* odir = (bf16_t*)a.out + (size_t)dir * M_ALL * DM;
    const float lg = type ? 0.f : ((const float*)(a.ws + WS_LG))[dir * 8 + h];
    const float sdec = __expf(lg * 64.0f);
    const int lrow0 = tid >> 4, lch = tid & 15;
    const size_t gcol = (size_t)h * 128 + lch * 8;
    const int vt = w & 3, it = w >> 2, dh = w >> 2;
    float ofac = 1.f, pfac = 1.f;
    f32x16 S0, S1;
    {
        if (grp) { const float* s0 = a.in[2 + type * 2 + dir] + (size_t)(b * 8 + h) * 16384;
#pragma unroll
            for (int t = 0; t < 16; ++t) { const int dd = (t & 3) + 8 * (t >> 2) + 4 * hh;
                S0[t] = s0[(size_t)(64 * dh + dd) * 128 + 32 * vt + r]; S1[t] = s0[(size_t)(64 * dh + 32 + dd) * 128 + 32 * vt + r]; } }
        else {
#pragma unroll
            for (int t = 0; t < 16; ++t) { S0[t] = 0.f; S1[t] = 0.f; } }
    }
    u32x4 pq[2], pk[2], pv[2]; float pe = 0.f;
#define CH_LOAD(c) do { const size_t rb_ = (size_t)(rowbase + 64 * (c)) * 1024 + gcol; \
        _Pragma("unroll") for (int u_ = 0; u_ < 2; ++u_) { const size_t o_ = rb_ + (size_t)(lrow0 + 32 * u_) * 1024; \
            pq[u_] = *(const u32x4*)(qs + o_); pk[u_] = *(const u32x4*)(ks_ + o_); pv[u_] = *(const u32x4*)(vs + o_); } \
        if (type && tid < 128) pe = EVg[((size_t)(((rowbase >> 6) + (c)) * 8 + h) * 2 + dir) * 128 + tid]; } while (0)
#define CH_STORE() do { \
        _Pragma("unroll") for (int u_ = 0; u_ < 2; ++u_) { const int row_ = lrow0 + 32 * u_; const unsigned o_ = off_b(row_, lch); \
            u32x4 kk_ = pk[u_]; if (!type) kk_ = scale_bf8(kk_, __expf(lg * (float)(dir ? row_ : 63 - row_))); \
            *(LAS u32x4*)(lds + L_QT + o_) = pq[u_]; *(LAS u32x4*)(lds + L_KT + o_) = kk_; *(LAS u32x4*)(lds + L_VT + o_) = pv[u_]; } \
        if (type && tid < 128) *(LAS float*)(lds + L_EV + 4 * tid) = pe; } while (0)
#define SI_STORE() do { \
        _Pragma("unroll") for (int g_ = 0; g_ < 4; ++g_) { \
            u32x2 x0_, x1_; x0_.x = cvtpk(S0[4 * g_], S0[4 * g_ + 1]); x0_.y = cvtpk(S0[4 * g_ + 2], S0[4 * g_ + 3]); x1_.x = cvtpk(S1[4 * g_], S1[4 * g_ + 1]); x1_.y = cvtpk(S1[4 * g_ + 2], S1[4 * g_ + 3]); \
            *(LAS u32x2*)(lds + L_SI + off_b(32 * vt + r, 4 * (2 * dh) + g_) + 8 * hh) = x0_; *(LAS u32x2*)(lds + L_SI + off_b(32 * vt + r, 4 * (2 * dh + 1) + g_) + 8 * hh) = x1_; } } while (0)

    if (!type) { const int i = 32 * it + r; ofac = __expf(lg * (float)(dir ? 64 - i : i + 1)); }
    CH_LOAD(dir ? nch - 1 : 0);
    __syncthreads();
    CH_STORE(); SI_STORE();
    __syncthreads();
    for (int step = 0; step < nch; ++step) {
        const int c = dir ? nch - 1 - step : step;
        const int row0 = rowbase + 64 * c;
        if (step + 1 < nch) CH_LOAD(dir ? c - 1 : c + 1);
        if (w < 4) {
            const int jt = w >> 1, it2 = w & 1;
            f32x16 acc;
#pragma unroll
            for (int t = 0; t < 16; ++t) acc[t] = 0.f;
#pragma unroll
            for (int s = 0; s < 8; ++s) { const bf16x8 A = *(const LAS bf16x8*)(lds + L_KT + off_b(32 * jt + r, 2 * s + hh)); const bf16x8 B = *(const LAS bf16x8*)(lds + L_QT + off_b(32 * it2 + r, 2 * s + hh));
                acc = MFMA32(A, B, acc); }
            const int i = 32 * it2 + r;
            if (!type) pfac = __expf(lg * (float)(dir ? -i : i - 63));
#pragma unroll
            for (int g = 0; g < 4; ++g) { float x[4];
#pragma unroll
                for (int e = 0; e < 4; ++e) { const int j = 32 * jt + 8 * g + 4 * hh + e; const bool keep = dir ? (j >= i) : (i >= j); x[e] = keep ? acc[4 * g + e] * pfac : 0.f; }
                u32x2 o; o.x = cvtpk(x[0], x[1]); o.y = cvtpk(x[2], x[3]);
                *(LAS u32x2*)(lds + L_PT + pt_off(i, 4 * jt + g) + 8 * hh) = o; }
        }
        __syncthreads();
        bf16x8 vf[4]; tr_frag4(lbase + L_VT, lane, vt, vf);
        f32x16 o1, o2;
#pragma unroll
        for (int t = 0; t < 16; ++t) { o1[t] = 0.f; o2[t] = 0.f; }
#pragma unroll
        for (int s = 0; s < 4; ++s) { const bf16x8 B = *(const LAS bf16x8*)(lds + L_PT + pt_off(32 * it + r, 2 * s + hh)); o1 = MFMA32(vf[s], B, o1); }
#pragma unroll
        for (int s = 0; s < 8; ++s) { const bf16x8 A = *(const LAS bf16x8*)(lds + L_SI + off_b(32 * vt + r, 2 * s + hh)); const bf16x8 B = *(const LAS bf16x8*)(lds + L_QT + off_b(32 * it + r, 2 * s + hh));
            o2 = MFMA32(A, B, o2); }
        {
            bf16_t* op = odir + (size_t)(row0 + 32 * it + r) * DM + type * 1024 + h * 128 + 32 * vt + 4 * hh;
#pragma unroll
            for (int g = 0; g < 4; ++g) { u32x2 o; o.x = cvtpk(o1[4 * g] + ofac * o2[4 * g], o1[4 * g + 1] + ofac * o2[4 * g + 1]); o.y = cvtpk(o1[4 * g + 2] + ofac * o2[4 * g + 2], o1[4 * g + 3] + ofac * o2[4 * g + 3]);
                *(u32x2*)(op + 8 * g) = o; }
        }
        if (!type) {
#pragma unroll
            for (int t = 0; t < 16; ++t) { S0[t] *= sdec; S1[t] *= sdec; } }
        {
            bf16x8 kf[4];
            tr_frag4(lbase + L_KT, lane, 2 * dh, kf);
#pragma unroll
            for (int s = 0; s < 4; ++s) S0 = MFMA32(kf[s], vf[s], S0);
            tr_frag4(lbase + L_KT, lane, 2 * dh + 1, kf);
#pragma unroll
            for (int s = 0; s < 4; ++s) S1 = MFMA32(kf[s], vf[s], S1);
        }
        if (type) {
#pragma unroll
            for (int g = 0; g < 4; ++g) { const f32x4 e0 = *(const LAS f32x4*)(lds + L_EV + 4 * (64 * dh + 8 * g + 4 * hh)), e1 = *(const LAS f32x4*)(lds + L_EV + 4 * (64 * dh + 32 + 8 * g + 4 * hh));
#pragma unroll
                for (int e = 0; e < 4; ++e) { S0[4 * g + e] *= e0[e]; S1[4 * g + e] *= e1[e]; } } }
        __syncthreads();
        SI_STORE();
        if (step + 1 < nch) CH_STORE();
        __syncthreads();
    }
    if (!grp) {
        float* so = a.out + (size_t)M_ALL * DM + (size_t)(type * 2 + dir) * (16 * 8 * 16384) + (size_t)(b * 8 + h) * 16384;
#pragma unroll
        for (int t = 0; t < 16; ++t) { const int dd = (t & 3) + 8 * (t >> 2) + 4 * hh;
            so[(size_t)(64 * dh + dd) * 128 + 32 * vt + r] = S0[t]; so[(size_t)(64 * dh + 32 + dd) * 128 + 32 * vt + r] = S1[t]; }
    }
#undef CH_LOAD
#undef CH_STORE
#undef SI_STORE
}
__device__ __forceinline__ void phase4(const Args& a, LAS unsigned char* lds) {
    const int G = gridDim.x, bx = blockIdx.x;
    if (G >= 128) {
        if (bx < 64) chain_item(a, lds, 1, bx >> 5, (bx >> 2) & 7, (bx >> 1) & 1, bx & 1);
        else for (int ci = bx - 64; ci < 512; ci += G - 64) chain_item(a, lds, 0, ci >> 5, (ci >> 2) & 7, (ci >> 1) & 1, ci & 1);
    } else {
        for (int L = bx; L < 576; L += G) { if (L < 64) chain_item(a, lds, 1, L >> 5, (L >> 2) & 7, (L >> 1) & 1, L & 1);
            else { const int ci = L - 64; chain_item(a, lds, 0, ci >> 5, (ci >> 2) & 7, (ci >> 1) & 1, ci & 1); } }
    }
}

__device__ __forceinline__ void phase4b(const Args& a) {
    const int NT = gridDim.x * 512;
    const bf16_t* of = (const bf16_t*)a.out; const bf16_t* ob = of + (size_t)M_ALL * DM;
    bf16_t* om = (bf16_t*)(a.ws + WS_OMIX);
    for (int idx = blockIdx.x * 512 + threadIdx.x; idx < M_ALL * 256; idx += NT) {
        const int l16 = idx & 15, seg = (idx >> 4) & 15, row = idx >> 8, type = seg >> 3, h = seg & 7;
        const size_t off = (size_t)row * DM + seg * 128 + l16 * 8;
        const u32x4 xf = *(const u32x4*)(of + off), xb = *(const u32x4*)(ob + off);
        const u32x4 gg = *(const u32x4*)(slotp(a, type ? 8 : 3) + (size_t)row * 1024 + h * 128 + l16 * 8);
        float o[8]; float ss = 0.f;
#pragma unroll
        for (int e = 0; e < 4; ++e) { o[2 * e] = bflo(xf[e]) + bflo(xb[e]); o[2 * e + 1] = bfhi(xf[e]) + bfhi(xb[e]); ss += o[2 * e] * o[2 * e] + o[2 * e + 1] * o[2 * e + 1]; }
        ss += __shfl_xor(ss, 1); ss += __shfl_xor(ss, 2); ss += __shfl_xor(ss, 4); ss += __shfl_xor(ss, 8);
        const float rstd = 1.0f / sqrtf(ss * (1.0f / 128.0f) + EPS);
        float wv[8];
        if (type) { const f32x4 w0 = *(const f32x4*)(a.in[14] + l16 * 8), w1 = *(const f32x4*)(a.in[14] + l16 * 8 + 4);
            wv[0] = w0.x; wv[1] = w0.y; wv[2] = w0.z; wv[3] = w0.w; wv[4] = w1.x; wv[5] = w1.y; wv[6] = w1.z; wv[7] = w1.w; }
        else {
#pragma unroll
            for (int e = 0; e < 8; ++e) wv[e] = 1.0f; }
        u32x4 res;
#pragma unroll
        for (int e = 0; e < 4; ++e) { const float g0 = bflo(gg[e]), g1 = bfhi(gg[e]);
            const float s0 = g0 / (1.0f + __expf(-g0)), s1 = g1 / (1.0f + __expf(-g1));
            res[e] = cvtpk(o[2 * e] * rstd * wv[2 * e] * s0, o[2 * e + 1] * rstd * wv[2 * e + 1] * s1); }
        *(u32x4*)(om + off) = res;
    }
}

struct EpiRes {
    static constexpr bool PERM = false, AFTER_DRAIN = false;
    const float* xp; const float* xsm; float* out; const float* gate;
    __device__ __forceinline__ void operator()(const pg8::f32x4 (&acc)[2][2][4][2], const pg8::Unit& u, int wr, int wc, int fr, int fq) const {
        const int row0 = u.pm * 256 + wr * 64 + fr, col0 = u.pn * 256 + wc * 32 + 4 * fq;
        const int m = (u.pm * 256 < M_CTX) ? 0 : 1 + ((u.pm * 256 - M_CTX) >> 12);
        pg8::f32x4 gv[2][2];
#pragma unroll
        for (int bj = 0; bj < 2; ++bj)
#pragma unroll
            for (int n = 0; n < 2; ++n) gv[bj][n] = *(const pg8::f32x4*)(gate + m * 2048 + col0 + bj * 128 + n * 16);
#pragma unroll
        for (int ai = 0; ai < 2; ++ai)
#pragma unroll
            for (int mm = 0; mm < 4; ++mm) { const int rr = row0 + ai * 128 + mm * 16;
                const float* xr = (rr < M_CTX ? xp + (size_t)rr * DM : xsm + (size_t)(rr - M_CTX) * DM) + col0; float* orow = out + (size_t)rr * DM + col0;
#pragma unroll
                for (int bj = 0; bj < 2; ++bj)
#pragma unroll
                    for (int n = 0; n < 2; ++n) { const pg8::f32x4 xv = *(const pg8::f32x4*)(xr + bj * 128 + n * 16); *(pg8::f32x4*)(orow + bj * 128 + n * 16) = xv + gv[bj][n] * acc[ai][bj][mm][n]; } }
    }
};

__device__ __forceinline__ void phase6(const Args& a) {
    const int tid = threadIdx.x, lane = tid & 63, wave = tid >> 6;
    const int gw = blockIdx.x * 8 + wave, NGW = gridDim.x * 8;
    const float* xs = (const float*)(a.ws + WS_XS);
    for (int row = gw; row < M_ALL; row += NGW) {
        const float* xr = xs + (size_t)row * DM; float* yr = a.out + (size_t)row * DM;
        f32x4 v[8]; float ss = 0.f;
#pragma unroll
        for (int j = 0; j < 8; ++j) { v[j] = *(const f32x4*)(xr + 4 * lane + 256 * j); ss += (v[j].x * v[j].x + v[j].y * v[j].y) + (v[j].z * v[j].z + v[j].w * v[j].w); }
        const float rstd = 1.0f / sqrtf(wave_sum(ss) * (1.0f / DM) + EPS);
#pragma unroll
        for (int j = 0; j < 8; ++j) { const f32x4 wv = *(const f32x4*)(a.in[16] + 4 * lane + 256 * j); *(f32x4*)(yr + 4 * lane + 256 * j) = v[j] * rstd * wv; }
    }
}

__global__ void __launch_bounds__(512, 2) hybrid_fwd(Args a) {
    extern __shared__ __attribute__((aligned(16))) unsigned char lds_raw[];
    LAS unsigned char* lds = (LAS unsigned char*)lds_raw;
    cg::grid_group grid = cg::this_grid();

    phase0(a, lds);
    grid.sync();
    phase1(a, lds);
    grid.sync();
    {
        pg8::Gemm g{(const pg8::bf16_t*)a.out, (const pg8::bf16_t*)(a.ws + WS_WINT), M_ALL, NIN, DM};
        pg8::StaticOrder S; S.init(M_ALL, NIN, (int)gridDim.x, (int)blockIdx.x);
        pg8::EpiBf16<0> E{(pg8::bf16_t*)(a.ws + WS_PROJ), 1024, nullptr, 1024, (size_t)M_ALL * 1024};
        pg8::gemm_phase<pg8::EpiBf16<0>, pg8::StaticOrder>(lds, g, S, E, nullptr);
    }
    grid.sync();
    phase3(a);
    grid.sync();
    phase4(a, lds);
    grid.sync();
    phase4b(a);
    grid.sync();
    {
        pg8::Gemm g{(const pg8::bf16_t*)(a.ws + WS_OMIX), (const pg8::bf16_t*)(a.ws + WS_WOUTT), M_ALL, DM, DM};
        pg8::StaticOrder S; S.init(M_ALL, DM, (int)gridDim.x, (int)blockIdx.x);
        EpiRes E{a.in[0], a.in[1], (float*)(a.ws + WS_XS), (const float*)(a.ws + WS_GATE)};
        pg8::gemm_phase<EpiRes, pg8::StaticOrder>(lds, g, S, E, nullptr);
    }
    grid.sync();
    phase6(a);
}

extern "C" void kernel_launch(void* const* d_in, const int* in_sizes, int n_in, void* d_out, int out_size, void* d_ws, size_t ws_size, hipStream_t stream) {
    static int grid = 0;
    if (grid == 0) {
        if (n_in != 17 || ws_size < WS_END) { fprintf(stderr, "kernel_launch: needs 17 inputs and %zu bytes of workspace (got %d, %zu)\n", (size_t)WS_END, n_in, ws_size); grid = -1; return; }
        int dev = 0, cus = 0, per_cu = 0;
        hipGetDevice(&dev); hipDeviceGetAttribute(&cus, hipDeviceAttributeMultiprocessorCount, dev);
        if (hipFuncSetAttribute((const void*)hybrid_fwd, hipFuncAttributeMaxDynamicSharedMemorySize, LDS_BYTES) != hipSuccess) { fprintf(stderr, "kernel_launch: hipFuncSetAttribute failed\n"); grid = -1; return; }
        if (hipOccupancyMaxActiveBlocksPerMultiprocessor(&per_cu, (const void*)hybrid_fwd, 512, LDS_BYTES) != hipSuccess || per_cu < 1) per_cu = 1;
        (void)hipGetLastError();
        grid = cus * per_cu;
    }
    if (grid < 0) return;
    Args a{};
    for (int i = 0; i < 17; ++i) a.in[i] = (const float*)d_in[i];
    a.out = (float*)d_out; a.ws = (unsigned char*)d_ws;
    void* args[] = {&a};
    hipError_t e = hipLaunchCooperativeKernel((const void*)hybrid_fwd, dim3(grid), dim3(512), args, LDS_BYTES, stream);
    if (e != hipSuccess) fprintf(stderr, "cooperative launch failed: %s (grid %d)\n", hipGetErrorString(e), grid);
}
```

```cpp
#include <hip/hip_runtime.h>
#include <hip/hip_cooperative_groups.h>
#include <cstdio>
namespace pg8 {
#define PG8_LAS __attribute__((address_space(3)))
typedef unsigned short bf16_t;
typedef short bf16x8 __attribute__((ext_vector_type(8)));
typedef float f32x4 __attribute__((ext_vector_type(4)));
typedef unsigned u32x4 __attribute__((ext_vector_type(4)));
constexpr int BM = 256, BK = 64, HALF = 128, HTB = HALF * BK * 2  , STAGE_BYTES = 8 * HTB, NXCD = 8, WGM = 8;

__host__ __device__ __forceinline__ int lds_byte(int r, int c) { const int st = (r >> 4) * 2 + (c >> 5), rr = r & 15, cc = c & 31, ob = rr * 64 + cc * 2; return st * 1024 + (ob ^ (((ob >> 9) & 1) << 5)); }
__host__ __device__ __forceinline__ void stage_rc(int b, int& R, int& C) { const int st = b / 1024, sb = b % 1024, swz = sb ^ (((sb >> 9) & 1) << 5); R = (st >> 1) * 16 + swz / 64; C = (st & 1) * 32 + (swz % 64) / 2; }
__host__ __device__ __forceinline__ int perm32(int rho) { const int n = rho >> 4, i = rho & 15; return 8 * (i >> 2) + 4 * n + (i & 3); }

struct Unit { int pm, pn; };
struct Gemm { const bf16_t* A; const bf16_t* Bt; int M, N, K; };

struct StaticOrder {
    int nM, nN, nwg, G, c;
    __host__ __device__ void init(int M, int N, int G_, int c_) { nM = M / BM; nN = N / BM; nwg = nM * nN; G = G_; c = c_; }
    __host__ __device__ bool next(int i, Unit& u) const {
        const long L = (long)i * G + c; if (L >= nwg) return false;
        int wgid = (int)L; { const int q = nwg / NXCD, r = nwg % NXCD, xcd = wgid % NXCD, off = wgid / NXCD; wgid = (xcd < r ? xcd * (q + 1) : r * (q + 1) + (xcd - r) * q) + off; }
        const int nig = WGM * nN, gid = wgid / nig, fm = gid * WGM, gsz = (nM - fm) < WGM ? (nM - fm) : WGM;
        u.pm = fm + ((wgid % nig) % gsz); u.pn = (wgid % nig) / gsz; return true;
    }
    __device__ __forceinline__ void a_ready(const Unit&) const {}
    __device__ __forceinline__ void done(const Unit&) const {}
};
struct CountedOrder : StaticOrder {
    const unsigned* ready; unsigned need; unsigned* tmo;
    __device__ __forceinline__ void a_ready(const Unit& u) const {
        if (threadIdx.x < 64) {
            const unsigned long long t0 = __builtin_amdgcn_s_memrealtime(); unsigned polls = 0;
            while ((unsigned)__builtin_amdgcn_readfirstlane(__hip_atomic_load(ready + 64 * u.pm, __ATOMIC_RELAXED, __HIP_MEMORY_SCOPE_AGENT)) < need) {
                if ((++polls & 255u) == 0u && __builtin_amdgcn_readfirstlane(__hip_atomic_load(tmo, __ATOMIC_RELAXED, __HIP_MEMORY_SCOPE_AGENT)) != 0u) break;
                if (__builtin_amdgcn_s_memrealtime() - t0 > 2000000ull) {
                    if (threadIdx.x == 0) { unsigned expect = 0u; __hip_atomic_compare_exchange_strong(tmo + 1, &expect, 0x600u | (unsigned)(u.pm & 0xff), __ATOMIC_RELAXED, __ATOMIC_RELAXED, __HIP_MEMORY_SCOPE_AGENT); __hip_atomic_store(tmo, 1u, __ATOMIC_RELAXED, __HIP_MEMORY_SCOPE_AGENT); }
                    break; }
                __builtin_amdgcn_s_sleep(2); }
            __builtin_amdgcn_fence(__ATOMIC_ACQUIRE, "agent");
            asm volatile("s_waitcnt vmcnt(0)" ::: "memory");
        }
#if !defined(BROKEN_HOOK_NO_BARRIER)
        asm volatile("" ::: "memory"); __builtin_amdgcn_s_barrier(); asm volatile("" ::: "memory");
#endif
    }
};

__device__ __forceinline__ unsigned cvt_pk_bf16(float lo, float hi) { unsigned r; asm volatile("v_cvt_pk_bf16_f32 %0, %1, %2" : "=v"(r) : "v"(lo), "v"(hi)); return r; }
typedef float f32x2 __attribute__((ext_vector_type(2)));
__device__ __forceinline__ f32x2 gelu_pk(f32x2 v) {
    const f32x2 av = __builtin_elementwise_abs(v), d = av * 0.2316418882f + 1.0f;
    f32x2 t; t.x = __builtin_amdgcn_rcpf(d.x); t.y = __builtin_amdgcn_rcpf(d.y);
    f32x2 q = t * 0.5307027145f + (-0.7265760135f); q = q * t + 0.7107068705f; q = q * t + (-0.142248368f); q = q * t + 0.127414796f; q = q * t;
    const f32x2 s = (v * v) * (-0.72134752044f);
    f32x2 e; e.x = __builtin_amdgcn_exp2f(s.x); e.y = __builtin_amdgcn_exp2f(s.y);
    const f32x2 m = v * (q * e), r = v - m;
    f32x2 o; o.x = v.x < 0.f ? m.x : r.x; o.y = v.y < 0.f ? m.y : r.y; return o;
}

struct EpiF32 {
    static constexpr bool PERM = false, AFTER_DRAIN = false;
    float* C; int ldc; const float* bias;
    __device__ __forceinline__ void operator()(const f32x4 (&acc)[2][2][4][2], const Unit& u, int wr, int wc, int fr, int fq) const {
        const int row0 = u.pm * BM + wr * 64 + fr, col0 = u.pn * BM + wc * 32 + 4 * fq;
        f32x4 bv[2][2];
#pragma unroll
        for (int bj = 0; bj < 2; ++bj)
#pragma unroll
            for (int n = 0; n < 2; ++n) bv[bj][n] = bias ? *(const f32x4*)(bias + col0 + bj * HALF + n * 16) : (f32x4){0.f, 0.f, 0.f, 0.f};
#pragma unroll
        for (int ai = 0; ai < 2; ++ai)
#pragma unroll
            for (int m = 0; m < 4; ++m) { float* rowp = C + (size_t)(row0 + ai * HALF + m * 16) * ldc + col0;
#pragma unroll
                for (int bj = 0; bj < 2; ++bj)
#pragma unroll
                    for (int n = 0; n < 2; ++n) *(f32x4*)(rowp + bj * HALF + n * 16) = acc[ai][bj][m][n] + bv[bj][n]; }
    }
};
template <int ACT  > struct EpiBf16 {
    static constexpr bool PERM = true, AFTER_DRAIN = false;
    bf16_t* O; int ldc; const float* bias; int split_cols; size_t split_stride;
    __device__ __forceinline__ void operator()(const f32x4 (&acc)[2][2][4][2], const Unit& u, int wr, int wc, int fr, int fq) const {
        const int row0 = u.pm * BM + wr * 64 + fr; int colt = u.pn * BM; bf16_t* base = O;
        if (split_cols) { const int t = colt / split_cols; base += (size_t)t * split_stride; colt -= t * split_cols; }
        const int col0 = colt + wc * 32 + 8 * fq, bcol0 = u.pn * BM + wc * 32 + 8 * fq;
        f32x4 bv[2][2];
#pragma unroll
        for (int bj = 0; bj < 2; ++bj)
#pragma unroll
            for (int n = 0; n < 2; ++n) bv[bj][n] = bias ? *(const f32x4*)(bias + bcol0 + bj * HALF + 4 * n) : (f32x4){0.f, 0.f, 0.f, 0.f};
#pragma unroll
        for (int ai = 0; ai < 2; ++ai)
#pragma unroll
            for (int m = 0; m < 4; ++m) { bf16_t* rowp = base + (size_t)(row0 + ai * HALF + m * 16) * ldc + col0;
#pragma unroll
                for (int bj = 0; bj < 2; ++bj) { f32x4 v0 = acc[ai][bj][m][0] + bv[bj][0], v1 = acc[ai][bj][m][1] + bv[bj][1];
                    if (ACT == 1) { f32x2 a = gelu_pk((f32x2){v0[0], v0[1]}), b = gelu_pk((f32x2){v0[2], v0[3]}), c = gelu_pk((f32x2){v1[0], v1[1]}), d = gelu_pk((f32x2){v1[2], v1[3]});
                        v0 = (f32x4){a.x, a.y, b.x, b.y}; v1 = (f32x4){c.x, c.y, d.x, d.y}; }
                    if (ACT == 2) {
#pragma unroll
                        for (int j = 0; j < 4; ++j) { v0[j] = 0.5f * v0[j] * (1.0f + erff(v0[j] * 0.70710678f)); v1[j] = 0.5f * v1[j] * (1.0f + erff(v1[j] * 0.70710678f)); } }
                    u32x4 w; w.x = cvt_pk_bf16(v0[0], v0[1]); w.y = cvt_pk_bf16(v0[2], v0[3]); w.z = cvt_pk_bf16(v1[0], v1[1]); w.w = cvt_pk_bf16(v1[2], v1[3]);
                    *(u32x4*)(rowp + bj * HALF) = w; } }
    }
};

struct PanelStats {
    unsigned* xbuf;
    unsigned* cnt;
    unsigned* tmo;
    int ntn; float eps;
    unsigned code;
    __device__ __forceinline__ bool run(const f32x4 (&v)[2][2][4][2], const Unit& u, int wr, int wc, int fr, int fq, PG8_LAS unsigned char* lds, int wid, int lane) const {
        typedef float f32x2v __attribute__((ext_vector_type(2)));
        PG8_LAS f32x2v* P = (PG8_LAS f32x2v*)lds;
        PG8_LAS f32x2v* S = (PG8_LAS f32x2v*)(lds + 8192);
        PG8_LAS unsigned* flag = (PG8_LAS unsigned*)(lds + 8192 + 2048);
#pragma unroll
        for (int ai = 0; ai < 2; ++ai)
#pragma unroll
            for (int m = 0; m < 4; ++m) {
                float s = 0.f;
#pragma unroll
                for (int bj = 0; bj < 2; ++bj)
#pragma unroll
                    for (int n = 0; n < 2; ++n) { const f32x4 x = v[ai][bj][m][n]; s += (x[0] + x[1]) + (x[2] + x[3]); }
                s += __shfl_xor(s, 16); s += __shfl_xor(s, 32);
                const float mw = s * (1.0f / 64.0f); float q = 0.f;
#pragma unroll
                for (int bj = 0; bj < 2; ++bj)
#pragma unroll
                    for (int n = 0; n < 2; ++n) { const f32x4 d = v[ai][bj][m][n] - mw; q += (d[0] * d[0] + d[1] * d[1]) + (d[2] * d[2] + d[3] * d[3]); }
                q += __shfl_xor(q, 16); q += __shfl_xor(q, 32);
                if (fq == 0) P[(ai * HALF + wr * 64 + m * 16 + fr) * 4 + wc] = (f32x2v){mw, q};
            }
        asm volatile("s_waitcnt lgkmcnt(0)" ::: "memory"); __builtin_amdgcn_s_barrier(); asm volatile("" ::: "memory");
#if defined(BROKEN_NO_WAIT)
        if (blockIdx.x >= 64) { const long long t0 = clock64(); while (clock64() - t0 < 60000) __builtin_amdgcn_s_sleep(8); }
#endif
        const int row = wid * 32 + (lane & 31);
        if (lane < 32) {
            const f32x2v a = P[row * 4 + 0], b = P[row * 4 + 1], c = P[row * 4 + 2], d = P[row * 4 + 3];
            const float mt = (a.x + b.x + c.x + d.x) * 0.25f;
            const float da = a.x - mt, db = b.x - mt, dc = c.x - mt, dd = d.x - mt;
            const float m2 = (a.y + b.y) + (c.y + d.y) + 64.0f * ((da * da + db * db) + (dc * dc + dd * dd));
            unsigned long long* slot = (unsigned long long*)xbuf + ((size_t)(u.pm * BM + row) * 4 + u.pn);
            __hip_atomic_store(slot, ((unsigned long long)__float_as_uint(m2) << 32) | __float_as_uint(mt), __ATOMIC_RELAXED, __HIP_MEMORY_SCOPE_AGENT);
        }
        asm volatile("s_waitcnt vmcnt(0)" ::: "memory");
        if (lane == 0) __hip_atomic_fetch_add(cnt + 64 * u.pm, 1u, __ATOMIC_RELAXED, __HIP_MEMORY_SCOPE_AGENT);
        if (wid == 0) {
            bool dead = false; const unsigned long long t0 = __builtin_amdgcn_s_memrealtime(); const unsigned want = 8u * (unsigned)ntn;
            for (;;) {
#if defined(BROKEN_NO_WAIT)
                break;
#endif
                if ((unsigned)__builtin_amdgcn_readfirstlane(__hip_atomic_load(cnt + 64 * u.pm, __ATOMIC_RELAXED, __HIP_MEMORY_SCOPE_AGENT)) >= want) break;
                if (__builtin_amdgcn_s_memrealtime() - t0 > 2000000ull) {
                    if (lane == 0) { unsigned expect = 0u; __hip_atomic_compare_exchange_strong(tmo + 1, &expect, code | (unsigned)(u.pm & 0xff), __ATOMIC_RELAXED, __ATOMIC_RELAXED, __HIP_MEMORY_SCOPE_AGENT);
                                     __hip_atomic_store(tmo, 1u, __ATOMIC_RELAXED, __HIP_MEMORY_SCOPE_AGENT); }
                    dead = true; break; }
                __builtin_amdgcn_s_sleep(2);
            }
            __builtin_amdgcn_fence(__ATOMIC_ACQUIRE, "agent");
            if (lane == 0) flag[0] = dead ? 1u : 0u;
        }
        asm volatile("s_waitcnt vmcnt(0) lgkmcnt(0)" ::: "memory"); __builtin_amdgcn_s_barrier(); asm volatile("" ::: "memory");
        const bool bad = flag[0] != 0u;
        if (lane < 32) {
            const unsigned long long* slot = (const unsigned long long*)xbuf + (size_t)(u.pm * BM + row) * 4; float mt[4], m2[4]; float ms = 0.f;
#pragma unroll
            for (int t = 0; t < 4; ++t) { if (t < ntn) { const unsigned long long w = __hip_atomic_load(slot + t, __ATOMIC_RELAXED, __HIP_MEMORY_SCOPE_AGENT); mt[t] = __uint_as_float((unsigned)w); m2[t] = __uint_as_float((unsigned)(w >> 32)); } else { mt[t] = 0.f; m2[t] = 0.f; } ms += mt[t]; }
            const float mean = ms / (float)ntn; float q = 0.f;
#pragma unroll
            for (int t = 0; t < 4; ++t) if (t < ntn) { const float dm = mt[t] - mean; q += m2[t] + 256.0f * dm * dm; }
            S[row] = (f32x2v){mean, 1.0f / sqrtf(q / (256.0f * (float)ntn) + eps)};
        }
        asm volatile("s_waitcnt lgkmcnt(0)" ::: "memory"); __builtin_amdgcn_s_barrier(); asm volatile("" ::: "memory");
        return bad;
    }
};
struct EpiLnRes {
    static constexpr bool PERM = false, AFTER_DRAIN = true;
    const float* base; float* out; int ldc; const float* bias; PanelStats st; unsigned poison;
    __device__ __forceinline__ void refuse(size_t i0, size_t stride, int M, int N) const { const float q = __builtin_nanf(""); for (size_t i = i0; i < (size_t)M * N; i += stride) out[(i / N) * ldc + i % N] = q;
        if (i0 == 0) { unsigned expect = 0u; __hip_atomic_compare_exchange_strong(st.tmo + 1, &expect, 0x7f0u, __ATOMIC_RELAXED, __ATOMIC_RELAXED, __HIP_MEMORY_SCOPE_AGENT); __hip_atomic_store(st.tmo, 1u, __ATOMIC_RELAXED, __HIP_MEMORY_SCOPE_AGENT); } }
    __device__ __forceinline__ void fused(f32x4 (&acc)[2][2][4][2], const Unit& u, int wr, int wc, int fr, int fq, PG8_LAS unsigned char* lds, int wid, int lane) const {
        typedef float f32x2v __attribute__((ext_vector_type(2)));
        const PG8_LAS f32x2v* S = (const PG8_LAS f32x2v*)(lds + 8192);
        const int col0 = u.pn * BM + wc * 32 + 4 * fq;
#pragma unroll
        for (int bj = 0; bj < 2; ++bj)
#pragma unroll
            for (int n = 0; n < 2; ++n) { const f32x4 bv = bias ? *(const f32x4*)(bias + col0 + bj * HALF + n * 16) : (f32x4){0.f, 0.f, 0.f, 0.f};
#pragma unroll
                for (int ai = 0; ai < 2; ++ai)
#pragma unroll
                    for (int m = 0; m < 4; ++m) acc[ai][bj][m][n] += bv; }
        const bool bad = st.run(acc, u, wr, wc, fr, fq, lds, wid, lane) || poison != 0u;
        const float qnan = __builtin_nanf("");
#pragma unroll
        for (int ai = 0; ai < 2; ++ai)
#pragma unroll
            for (int m = 0; m < 4; ++m) { const int r = ai * HALF + wr * 64 + m * 16 + fr; const f32x2v sr = S[r]; const size_t off = (size_t)(u.pm * BM + r) * ldc + col0;
#pragma unroll
                for (int bj = 0; bj < 2; ++bj)
#pragma unroll
                    for (int n = 0; n < 2; ++n) { const f32x4 bs = *(const f32x4*)(base + off + bj * HALF + n * 16); f32x4 o = bs + (acc[ai][bj][m][n] - sr.x) * sr.y;
                        if (bad) o = (f32x4){qnan, qnan, qnan, qnan}; *(f32x4*)(out + off + bj * HALF + n * 16) = o; }
                asm volatile("" ::: "memory"); }
    }
};
struct EpiLnResLn {
    static constexpr bool PERM = false, AFTER_DRAIN = true;
    const float* base; float* out; bf16_t* xn; int ldc; const float* bias; PanelStats st1, st2; unsigned poison;
    __device__ __forceinline__ void refuse(size_t i0, size_t stride, int M, int N) const { const float q = __builtin_nanf(""); for (size_t i = i0; i < (size_t)M * N; i += stride) { const size_t o = (i / N) * ldc + i % N; out[o] = q; xn[o] = (bf16_t)0x7fc0u; }
        if (i0 == 0) { unsigned expect = 0u; __hip_atomic_compare_exchange_strong(st1.tmo + 1, &expect, 0x7f0u, __ATOMIC_RELAXED, __ATOMIC_RELAXED, __HIP_MEMORY_SCOPE_AGENT); __hip_atomic_store(st1.tmo, 1u, __ATOMIC_RELAXED, __HIP_MEMORY_SCOPE_AGENT); } }
    __device__ __forceinline__ void fused(f32x4 (&acc)[2][2][4][2], const Unit& u, int wr, int wc, int fr, int fq, PG8_LAS unsigned char* lds, int wid, int lane) const {
        typedef float f32x2v __attribute__((ext_vector_type(2))); typedef unsigned u32x2v __attribute__((ext_vector_type(2)));
        const PG8_LAS f32x2v* S = (const PG8_LAS f32x2v*)(lds + 8192);
        const int col0 = u.pn * BM + wc * 32 + 4 * fq;
#pragma unroll
        for (int bj = 0; bj < 2; ++bj)
#pragma unroll
            for (int n = 0; n < 2; ++n) { const f32x4 bv = bias ? *(const f32x4*)(bias + col0 + bj * HALF + n * 16) : (f32x4){0.f, 0.f, 0.f, 0.f};
#pragma unroll
                for (int ai = 0; ai < 2; ++ai)
#pragma unroll
                    for (int m = 0; m < 4; ++m) acc[ai][bj][m][n] += bv; }
        bool bad = st1.run(acc, u, wr, wc, fr, fq, lds, wid, lane) || poison != 0u;
        const float qnan = __builtin_nanf("");
#pragma unroll
        for (int ai = 0; ai < 2; ++ai)
#pragma unroll
            for (int m = 0; m < 4; ++m) { const int r = ai * HALF + wr * 64 + m * 16 + fr; const f32x2v sr = S[r]; const size_t off = (size_t)(u.pm * BM + r) * ldc + col0;
#pragma unroll
                for (int bj = 0; bj < 2; ++bj)
#pragma unroll
                    for (int n = 0; n < 2; ++n) { const f32x4 bs = *(const f32x4*)(base + off + bj * HALF + n * 16); acc[ai][bj][m][n] = bs + (acc[ai][bj][m][n] - sr.x) * sr.y; }
                asm volatile("" : "+v"(acc[ai][0][m][0]), "+v"(acc[ai][0][m][1]), "+v"(acc[ai][1][m][0]), "+v"(acc[ai][1][m][1]));
                if (m & 1) asm volatile("" ::: "memory"); }
        const bool bad1 = bad;
        bad = st2.run(acc, u, wr, wc, fr, fq, lds, wid, lane) || bad;
#pragma unroll
        for (int ai = 0; ai < 2; ++ai)
#pragma unroll
            for (int m = 0; m < 4; ++m) { const int r = ai * HALF + wr * 64 + m * 16 + fr; const f32x2v sr = S[r]; const size_t off = (size_t)(u.pm * BM + r) * ldc + col0;
#pragma unroll
                for (int bj = 0; bj < 2; ++bj)
#pragma unroll
                    for (int n = 0; n < 2; ++n) { const f32x4 x1 = acc[ai][bj][m][n]; *(f32x4*)(out + off + bj * HALF + n * 16) = bad1 ? (f32x4){qnan, qnan, qnan, qnan} : x1;
                        const f32x4 o = (x1 - sr.x) * sr.y; u32x2v w; w.x = cvt_pk_bf16(o[0], o[1]); w.y = cvt_pk_bf16(o[2], o[3]);
                        if (bad) { w.x = 0x7fc07fc0u; w.y = 0x7fc07fc0u; } *(u32x2v*)(xn + off + bj * HALF + n * 16) = w; }
                asm volatile("" ::: "memory"); }
    }
};

template <class Epi, class Sched, bool STAMP = false>
__device__ __forceinline__ void gemm_phase(PG8_LAS unsigned char* lds, const Gemm g, const Sched& S, const Epi& E, unsigned long long* stamps) {
    int tid_ = threadIdx.x; asm volatile("" : "+v"(tid_));
    const int tid = tid_, wid = __builtin_amdgcn_readfirstlane(tid >> 6), lane = tid & 63, wr = wid >> 2, wc = wid & 3, fr = lane & 15, fq = lane >> 4;
    const int K = g.K, nt = K / BK;
    int ts_lo = 0, ts_hi = 0, nts = 0; const unsigned long long rt_entry = STAMP ? (unsigned long long)wall_clock64() : 0ull;
#define PG8_STAMP() do { if (STAMP && wid == 0 && nts < 64) { const unsigned long long _c = (unsigned long long)clock64(); \
        ts_lo = (lane == nts) ? (int)(unsigned)_c : ts_lo; ts_hi = (lane == nts) ? (int)(unsigned)(_c >> 32) : ts_hi; ++nts; } } while (0)
    PG8_STAMP();
    unsigned voffA[2], voffB[2];
#pragma unroll
    for (int i = 0; i < 2; ++i) { int R, C; stage_rc(tid * 16 + i * 8192, R, C); const int Rb = Epi::PERM ? ((R & ~31) + perm32(R & 31)) : R;
        voffA[i] = (unsigned)(R * K + C) * 2u; voffB[i] = (unsigned)(Rb * K + C) * 2u; }
    const size_t kstep = (size_t)(BK * 2);
    const size_t hstep = (size_t)HALF * K * 2;
    const size_t tstep = 2 * hstep;
    const unsigned ldsw = (unsigned)wid * 1024u;
    const int aoff = lds_byte(wr * 64 + fr, fq * 8), boff = lds_byte(wc * 32 + fr, fq * 8);
#define PG8_SA(b, h) (((b) * 2 + (h)) * HTB)
#define PG8_SB(b, h) ((4 + (b) * 2 + (h)) * HTB)
#define PG8_STAGE(bufoff, gbase, voff) do { _Pragma("unroll") for (int _i = 0; _i < 2; ++_i) \
        __builtin_amdgcn_global_load_lds((const unsigned*)((const char*)(gbase) + (voff)[_i]), (PG8_LAS unsigned*)(lds + (bufoff) + ldsw + _i * 8192), 16, 0, 0); } while (0)
#define PG8_LDA(dst, b, h) do { _Pragma("unroll") for (int m = 0; m < 4; ++m) _Pragma("unroll") for (int k = 0; k < 2; ++k) dst[m][k] = *(const PG8_LAS bf16x8*)(lds + PG8_SA(b, h) + aoff + m * 2048 + k * 1024); } while (0)
#define PG8_LDB(dst, b, h) do { _Pragma("unroll") for (int n = 0; n < 2; ++n) _Pragma("unroll") for (int k = 0; k < 2; ++k) dst[n][k] = *(const PG8_LAS bf16x8*)(lds + PG8_SB(b, h) + boff + n * 2048 + k * 1024); } while (0)
#define PG8_MMA(ai, bj, At, Bt) do { __builtin_amdgcn_s_setprio(1); _Pragma("unroll") for (int m = 0; m < 4; ++m) _Pragma("unroll") for (int n = 0; n < 2; ++n) _Pragma("unroll") for (int k = 0; k < 2; ++k) \
        acc[ai][bj][m][n] = __builtin_amdgcn_mfma_f32_16x16x32_bf16(Bt[n][k], At[m][k], acc[ai][bj][m][n], 0, 0, 0); __builtin_amdgcn_s_setprio(0); } while (0)
#define PG8_WAIT_V(n) asm volatile("s_waitcnt vmcnt(" #n ")" ::: "memory")
#define PG8_WAIT_L(n) asm volatile("s_waitcnt lgkmcnt(" #n ")" ::: "memory")
#define PG8_BAR __builtin_amdgcn_s_barrier()
#define PG8_SCHED __builtin_amdgcn_sched_barrier(0)
    Unit cur, nxt; int ui = 0;
    if (!S.next(0, cur)) return;
    f32x4 acc[2][2][4][2];
#pragma unroll
    for (int a = 0; a < 2; ++a)
#pragma unroll
        for (int b = 0; b < 2; ++b)
#pragma unroll
            for (int m = 0; m < 4; ++m)
#pragma unroll
                for (int n = 0; n < 2; ++n) acc[a][b][m][n] = (f32x4){0.f, 0.f, 0.f, 0.f};
    bf16x8 At[4][2], B0[2][2], B1[2][2];
    const char* cA = (const char*)g.A + (size_t)cur.pm * tstep; const char* cB = (const char*)g.Bt + (size_t)cur.pn * tstep;
    S.a_ready(cur);
    PG8_STAGE(PG8_SB(0, 0), cB, voffB); PG8_STAGE(PG8_SA(0, 0), cA, voffA); PG8_STAGE(PG8_SB(0, 1), cB + hstep, voffB); PG8_STAGE(PG8_SA(0, 1), cA + hstep, voffA);
    if (wr == 1) PG8_BAR;
    PG8_WAIT_V(4); PG8_BAR;
    PG8_STAGE(PG8_SB(1, 0), cB + kstep, voffB); PG8_STAGE(PG8_SA(1, 0), cA + kstep, voffA); PG8_STAGE(PG8_SB(1, 1), cB + hstep + kstep, voffB);
    PG8_WAIT_V(6); PG8_BAR;
    PG8_STAMP();
    for (;;) {
        const bool has_next = S.next(ui + 1, nxt);
        const char* nA = has_next ? (const char*)g.A + (size_t)nxt.pm * tstep : cA; const char* nB = has_next ? (const char*)g.Bt + (size_t)nxt.pn * tstep : cB;
        for (int t = 0; t < nt; t += 2) {
            const bool last = (t == nt - 2);
            const char* a1 = cA + (size_t)(t + 1) * kstep;
            const char* a2 = last ? nA : cA + (size_t)(t + 2) * kstep; const char* b2 = last ? nB : cB + (size_t)(t + 2) * kstep;
            const char* a3 = a2 + kstep; const char* b3 = b2 + kstep;
            if (last && has_next) S.a_ready(nxt);
            PG8_LDB(B0, 0, 0); PG8_SCHED; PG8_LDA(At, 0, 0); PG8_STAGE(PG8_SA(1, 1), a1 + hstep, voffA);
            PG8_WAIT_L(8); PG8_BAR; PG8_WAIT_L(0); PG8_MMA(0, 0, At, B0); PG8_BAR; PG8_SCHED;
            PG8_LDB(B1, 0, 1); PG8_STAGE(PG8_SB(0, 0), b2, voffB);
            PG8_BAR; PG8_WAIT_L(0); PG8_MMA(0, 1, At, B1); PG8_BAR;
            PG8_LDA(At, 0, 1); PG8_STAGE(PG8_SA(0, 0), a2, voffA);
            PG8_BAR; PG8_WAIT_L(0); PG8_MMA(1, 0, At, B0); PG8_BAR; PG8_SCHED;
            PG8_STAGE(PG8_SB(0, 1), b2 + hstep, voffB);
            PG8_WAIT_V(6); PG8_BAR; PG8_MMA(1, 1, At, B1); PG8_BAR;
            PG8_LDB(B0, 1, 0); PG8_SCHED; PG8_LDA(At, 1, 0); PG8_STAGE(PG8_SA(0, 1), a2 + hstep, voffA);
            PG8_WAIT_L(8); PG8_BAR; PG8_WAIT_L(0); PG8_MMA(0, 0, At, B0); PG8_BAR; PG8_SCHED;
            PG8_LDB(B1, 1, 1); PG8_STAGE(PG8_SB(1, 0), b3, voffB);
            PG8_BAR; PG8_WAIT_L(0); PG8_MMA(0, 1, At, B1); PG8_BAR;
            PG8_LDA(At, 1, 1); PG8_STAGE(PG8_SA(1, 0), a3, voffA);
            PG8_BAR; PG8_WAIT_L(0); PG8_MMA(1, 0, At, B0); PG8_BAR; PG8_SCHED;
            PG8_STAGE(PG8_SB(1, 1), b3 + hstep, voffB);
            PG8_WAIT_V(6); PG8_BAR; PG8_MMA(1, 1, At, B1); PG8_BAR;
        }
        PG8_STAMP();
        if constexpr (!Epi::AFTER_DRAIN) { E(acc, cur, wr, wc, fr, fq); S.done(cur); }
        PG8_STAMP();
        if (!has_next) break;
#pragma unroll
        for (int a = 0; a < 2; ++a)
#pragma unroll
            for (int b = 0; b < 2; ++b)
#pragma unroll
                for (int m = 0; m < 4; ++m)
#pragma unroll
                    for (int n = 0; n < 2; ++n) acc[a][b][m][n] = (f32x4){0.f, 0.f, 0.f, 0.f};
        cur = nxt; cA = nA; cB = nB; ++ui;
    }
    PG8_WAIT_V(0);
    if (wr == 0) PG8_BAR;
    PG8_BAR;
    if constexpr (Epi::AFTER_DRAIN) { E.fused(acc, cur, wr, wc, fr, fq, lds, wid, lane); S.done(cur); }
    PG8_STAMP();
    if (STAMP && wid == 0) { stamps[lane] = lane < nts ? (((unsigned long long)(unsigned)ts_hi << 32) | (unsigned)ts_lo) : 0ull;
        if (lane == 62) stamps[62] = rt_entry; if (lane == 63) stamps[63] = (unsigned long long)wall_clock64(); }
#undef PG8_STAMP
#undef PG8_SA
#undef PG8_SB
#undef PG8_STAGE
#undef PG8_LDA
#undef PG8_LDB
#undef PG8_MMA
#undef PG8_WAIT_V
#undef PG8_WAIT_L
#undef PG8_BAR
#undef PG8_SCHED
}
}

namespace cg = cooperative_groups;
#define LAS __attribute__((address_space(3)))
typedef unsigned short bf16_t;
typedef short bf16x8 __attribute__((ext_vector_type(8)));
typedef short s16x4 __attribute__((ext_vector_type(4)));
typedef float f32x4 __attribute__((ext_vector_type(4)));
typedef float f32x16 __attribute__((ext_vector_type(16)));
typedef unsigned u32x4 __attribute__((ext_vector_type(4)));
typedef unsigned u32x2 __attribute__((ext_vector_type(2)));

constexpr int DM = 2048, M_CTX = 4096, M_ALL = 12288, NIN = 9216;
constexpr float EPS = 1e-6f;
constexpr size_t SLOT = (size_t)M_ALL * 1024 * 2;
constexpr size_t WS_PROJ = 0;
constexpr size_t WS_WINT = 9 * SLOT;
constexpr size_t WS_WOUTT = 11 * SLOT;
constexpr size_t WS_PART = WS_WOUTT + (size_t)2048 * 2048 * 2;
constexpr size_t WS_GATE = WS_PART + (size_t)16 * 3 * 6144 * 4;
constexpr size_t WS_MOD = WS_GATE + 3 * 2048 * 4;
constexpr size_t WS_EVEC = WS_MOD + 3 * 6144 * 4;
constexpr size_t WS_ROPE = WS_EVEC + (size_t)192 * 8 * 2 * 128 * 4;
constexpr size_t WS_LB = WS_ROPE + 64 * 32 * 2 * 4;
constexpr size_t WS_LG = WS_LB + 2 * 1024 * 4;
constexpr size_t WS_BAR = WS_LG + 256;
constexpr size_t WS_PCNT = WS_BAR + 16384;
constexpr size_t WS_BAR2 = WS_PCNT + 48 * 256;
constexpr size_t WS_XCH = WS_BAR2 + 16384;
constexpr size_t WS_END = WS_XCH + (size_t)M_ALL * 8 * 4;
constexpr size_t WS_OMIX = 4 * SLOT;
constexpr size_t WS_XS = 0;
constexpr int LDS_BYTES = 163840;

struct Args { const float* in[17]; float* out; unsigned char* ws; };
__device__ __forceinline__ size_t pk2_off(int row, int col) { return ((size_t)((row >> 6) * 16 + (col >> 7)) * 64 + (row & 63)) * 128 + (col & 127); }
__device__ __forceinline__ size_t pk_off(int row, int col) { return ((size_t)((row >> 6) * 8 + (col >> 7)) * 64 + (row & 63)) * 128 + (col & 127); }
#ifndef REP_LAT
#define REP_LAT 1
#endif
#ifndef REP_P0
#define REP_P0 1
#endif
#ifndef REP_P1
#define REP_P1 1
#endif
#ifndef REP_P2
#define REP_P2 1
#endif
#ifndef REP_P4
#define REP_P4 1
#endif
#ifndef REP_P4B
#define REP_P4B 1
#endif
#ifndef REP_P5
#define REP_P5 1
#endif
#ifndef REP_P6
#define REP_P6 1
#endif

__device__ __forceinline__ unsigned cvtpk(float lo, float hi) { unsigned r; asm volatile("v_cvt_pk_bf16_f32 %0, %1, %2" : "=v"(r) : "v"(lo), "v"(hi)); return r; }
__device__ __forceinline__ float bflo(unsigned u) { return __builtin_bit_cast(float, u << 16); }
__device__ __forceinline__ float bfhi(unsigned u) { return __builtin_bit_cast(float, u & 0xffff0000u); }
__device__ __forceinline__ float bf2f(bf16_t b) { return __builtin_bit_cast(float, (unsigned)b << 16); }
__device__ __forceinline__ float wave_sum(float v) {
#pragma unroll
    for (int o = 1; o < 64; o <<= 1) v += __shfl_xor(v, o);
    return v;
}
#define LDS_WAIT() asm volatile("s_waitcnt lgkmcnt(0)" ::: "memory")
#define BAR_LDS() do { asm volatile("s_waitcnt lgkmcnt(0)" ::: "memory"); __builtin_amdgcn_s_barrier(); asm volatile("" ::: "memory"); } while (0)
#define MFMA32(a, b, c) __builtin_amdgcn_mfma_f32_32x32x16_bf16((a), (b), (c), 0, 0, 0)
#define PRIO_HI() __builtin_amdgcn_s_setprio(1)
#define PRIO_LO() __builtin_amdgcn_s_setprio(0)

#define RLX_AGENT __ATOMIC_RELAXED, __HIP_MEMORY_SCOPE_AGENT
#define XB_TMO      128
#define XB_XCNT(j)  (256  + 64 * (j))
#define XB_XSUB(j)  (1280 + 64 * (j))
#define XB_XGEN(j)  (2304 + 64 * (j))
#define XB_TOP      3328
#define XB_TOPGEN   3392
#define XCD_BAR_WORDS 3456
#define XB_SPIN_CAP (1u << 18)

__device__ __forceinline__ unsigned xb_ld(unsigned* p)              { return __hip_atomic_load(p, __ATOMIC_RELAXED, __HIP_MEMORY_SCOPE_AGENT); }
__device__ __forceinline__ unsigned xb_add(unsigned* p, unsigned v) { return __hip_atomic_fetch_add(p, v, __ATOMIC_RELAXED, __HIP_MEMORY_SCOPE_AGENT); }
__device__ __forceinline__ unsigned xb_xcc_id() { return (unsigned)__builtin_amdgcn_s_getreg((3 << 11) | 20) & 0xFu; }
#define XB_SPIN(cond, bar) do { unsigned _sp = 0; while (cond) { __builtin_amdgcn_s_sleep(1); \
    if ((++_sp & 255u) == 0u) { if (xb_ld(&(bar)[XB_TMO])) break; if (_sp > XB_SPIN_CAP) { atomicAdd(&(bar)[XB_TMO], 1u); break; } } } } while (0)

struct XcdBarrier {
    unsigned* bar; unsigned x; unsigned G;
    volatile LAS unsigned* st;
};

__device__ __forceinline__ XcdBarrier xcd_barrier_post(unsigned* bar, volatile LAS unsigned* st, unsigned members) {
    XcdBarrier b; b.bar = bar; b.x = xb_xcc_id(); b.st = st; b.G = members;
    if (threadIdx.x == 0) (void)xb_add(&bar[XB_XCNT(b.x)], 1u);
    return b;
}
__device__ __forceinline__ void xcd_barrier_complete(unsigned* bar, unsigned x, unsigned G, unsigned& nloc, unsigned& nx) {
    unsigned sum, cnt, mine, sp = 0u;
    for (;;) {
        sum = 0u; cnt = 0u; mine = 0u;
#pragma unroll
        for (unsigned j = 0; j < 16; ++j) { const unsigned c = xb_ld(&bar[XB_XCNT(j)]); sum += c; cnt += (c > 0u) ? 1u : 0u; mine = (j == x) ? c : mine; }
        if (sum == G) break;
        __builtin_amdgcn_s_sleep(1);
        if ((++sp & 255u) == 0u) { if (xb_ld(&bar[XB_TMO])) break; if (sp > XB_SPIN_CAP) { atomicAdd(&bar[XB_TMO], 1u); break; } }
    }
    nloc = mine > 0u ? mine : 1u; nx = cnt > 0u ? cnt : 1u;
}

__device__ __forceinline__ void xcd_barrier(const XcdBarrier& b) {
    asm volatile("s_waitcnt vmcnt(0)" ::: "memory");
    __syncthreads();
    if (threadIdx.x == 0) {
        unsigned* bar = b.bar;
        __builtin_amdgcn_s_waitcnt(0);
        unsigned nloc = b.st[0], nx = b.st[1];
        if (nloc == 0u) { xcd_barrier_complete(bar, b.x, b.G, nloc, nx); b.st[0] = nloc; b.st[1] = nx; }
        const unsigned old = xb_add(&bar[XB_XSUB(b.x)], 1u);
        const unsigned gen = old / nloc;
        if (old + 1u == (gen + 1u) * nloc) {
            __builtin_amdgcn_fence(__ATOMIC_RELEASE, "agent");
            asm volatile("s_waitcnt vmcnt(0)" ::: "memory");
            const unsigned og = xb_add(&bar[XB_TOP], 1u);
            const unsigned tg = og / nx;
            if (og + 1u == (tg + 1u) * nx) xb_add(&bar[XB_TOPGEN], 1u);
            else XB_SPIN(xb_ld(&bar[XB_TOPGEN]) == tg, bar);
            __builtin_amdgcn_fence(__ATOMIC_ACQUIRE, "agent");
            xb_add(&bar[XB_XGEN(b.x)], 1u);
            asm volatile("s_waitcnt vmcnt(0)" ::: "memory");
        } else {
            XB_SPIN(xb_ld(&bar[XB_XGEN(b.x)]) == gen, bar);
            __builtin_amdgcn_fence(__ATOMIC_ACQUIRE, "agent");
            asm volatile("s_waitcnt vmcnt(0)" ::: "memory");
        }
    }
    __syncthreads();
}

__device__ __forceinline__ void sub_barrier(unsigned* cnt, unsigned nblk, unsigned& gen) {
    asm volatile("s_waitcnt vmcnt(0)" ::: "memory");
    __syncthreads();
    if (threadIdx.x == 0) {
        __builtin_amdgcn_fence(__ATOMIC_RELEASE, "agent");
        asm volatile("s_waitcnt vmcnt(0)" ::: "memory");
        xb_add(cnt, 1u);
        const unsigned target = (gen + 1u) * nblk; unsigned sp = 0u;
        while (xb_ld(cnt) < target) { __builtin_amdgcn_s_sleep(1); if (++sp > (1u << 22)) break; }
        __builtin_amdgcn_fence(__ATOMIC_ACQUIRE, "agent");
        asm volatile("s_waitcnt vmcnt(0)" ::: "memory");
    }
    ++gen;
    __syncthreads();
}

__device__ __forceinline__ void p0_transpose_item(const float* W, int K, int N, bf16_t* WT, LAS float* scr, int item, int lane, int sc_lo, int sc_hi, float scale, int rope_cols) {
    const int nblk = N / 32, kb = item / nblk, nb = item % nblk, k0 = 64 * kb, n0 = 32 * nb;
    const float sc = (n0 >= sc_lo && n0 < sc_hi) ? scale : 1.0f;
    {
        f32x4 t[8];
        int csrc = n0 + 4 * (lane & 7);
        if (csrc < rope_cols) { const int pp = csrc & 127; csrc = (csrc & ~127) + 64 * (pp >> 6) + 4 * ((pp >> 3) & 7) + 32 * ((pp >> 2) & 1); }
#pragma unroll
        for (int i = 0; i < 8; ++i) t[i] = __builtin_nontemporal_load((const f32x4*)(W + (size_t)(k0 + (lane >> 3) + 8 * i) * N + csrc));
#pragma unroll
        for (int i = 0; i < 8; ++i) { LAS float* d = scr + ((lane >> 3) + 8 * i) * 33 + 4 * (lane & 7); d[0] = t[i].x * sc; d[1] = t[i].y * sc; d[2] = t[i].z * sc; d[3] = t[i].w * sc; }
    }
    LDS_WAIT();
    const int c = lane & 7;
#pragma unroll
    for (int j = 0; j < 4; ++j) { const int n = (lane >> 3) + 8 * j; const LAS float* s = scr + (8 * c) * 33 + n;
        u32x4 o; o.x = cvtpk(s[0 * 33], s[1 * 33]); o.y = cvtpk(s[2 * 33], s[3 * 33]); o.z = cvtpk(s[4 * 33], s[5 * 33]); o.w = cvtpk(s[6 * 33], s[7 * 33]);
        *(u32x4*)(WT + (size_t)(n0 + n) * K + k0 + 8 * c) = o; }
    LDS_WAIT();
}
__device__ __forceinline__ void p0_gemv_task(const Args& a, int task, LAS float* scr, int lane) {
    const int cgp = task % 24, ks = task / 24;
#pragma unroll
    for (int m = 0; m < 3; ++m)
#pragma unroll
        for (int hf = 0; hf < 2; ++hf) { const int k = 128 * ks + 64 * hf + lane; const float c = (m == 0) ? a.in[7][k] : a.in[6][(m - 1) * 2048 + k];
            scr[m * 128 + 64 * hf + lane] = c / (1.0f + __expf(-c)); }
    LDS_WAIT();
    const float* w = a.in[9] + (size_t)(128 * ks) * 6144 + 256 * cgp + 4 * lane;
    f32x4 a0 = {0.f, 0.f, 0.f, 0.f}, a1 = a0, a2 = a0;
#pragma unroll 16
    for (int kk = 0; kk < 128; ++kk) { const f32x4 wv = __builtin_nontemporal_load((const f32x4*)(w + (size_t)kk * 6144)); a0 += scr[kk] * wv; a1 += scr[128 + kk] * wv; a2 += scr[256 + kk] * wv; }
    float* part = (float*)(a.ws + WS_PART) + (size_t)(ks * 3) * 6144 + 256 * cgp + 4 * lane;
    *(f32x4*)(part) = a0; *(f32x4*)(part + 6144) = a1; *(f32x4*)(part + 2 * 6144) = a2;
    LDS_WAIT();
}
__device__ __forceinline__ void phase0(const Args& a, LAS unsigned char* lds) {
    const int tid = threadIdx.x, lane = tid & 63, wave = tid >> 6;
    LAS float* scr = (LAS float*)(lds + wave * 16384);
    const int gw = blockIdx.x * 8 + wave, NGW = gridDim.x * 8;
    constexpr int T_GEMV = 24 * 16, T_WIN = 32 * (NIN / 32), T_WOUT = 32 * (2048 / 32);
    for (int t = gw; t < T_GEMV + T_WIN + T_WOUT; t += NGW) {
        const int q30 = t / 30, ng = (t + 29) / 30 < T_GEMV ? (t + 29) / 30 : T_GEMV;
        if (t % 30 == 0 && q30 < T_GEMV) { p0_gemv_task(a, q30, scr, lane); continue; }
        const int it = t - ng;
        if (it < T_WIN) p0_transpose_item(a.in[11], 2048, NIN, (bf16_t*)(a.ws + WS_WINT), scr, it, lane, 1024, 2048, 0.08838834764831845f, 2048);
        else p0_transpose_item(a.in[15], 2048, 2048, (bf16_t*)(a.ws + WS_WOUTT), scr, it - T_WIN, lane, 0, 0, 1.0f, 0);
    }
    const int gt = blockIdx.x * 512 + tid;
    if (gt < 2048) { const int pos = gt >> 5, f = gt & 31; const float fr = powf(10000.0f, -(float)f / 32.0f); const float ang = (float)pos * fr;
        float* r = (float*)(a.ws + WS_ROPE); r[2 * gt] = cosf(ang); r[2 * gt + 1] = sinf(ang); }
    else if (gt < 4096) { const int i = gt - 2048, dir = i >> 10, col = i & 1023; const float x0 = a.in[13][dir * 2048 + col], x1 = a.in[13][dir * 2048 + 1024 + col];
        ((float*)(a.ws + WS_LB))[i] = 1.0f / (1.0f + expf(x1 - x0)); }
    else if (gt < 4096 + 16) { const int i = gt - 4096; ((float*)(a.ws + WS_LG))[i] = log1pf(-expf(a.in[12][i])); }
}

__device__ __forceinline__ void phase0b(const Args& a) {
    const float* part = (const float*)(a.ws + WS_PART);
    for (int idx = blockIdx.x * 512 + threadIdx.x; idx < 3 * 6144; idx += gridDim.x * 512) { const int m = idx / 6144, c = idx % 6144; float sacc = a.in[10][c];
#pragma unroll
        for (int ks = 0; ks < 16; ++ks) sacc += part[(size_t)(ks * 3 + m) * 6144 + c];
        ((float*)(a.ws + WS_MOD))[idx] = sacc;
        if (c >= 4096) ((float*)(a.ws + WS_GATE))[m * 2048 + c - 4096] = sacc; }
}

__device__ __forceinline__ void phase1(const Args& a, LAS unsigned char* lds) {
    const int tid = threadIdx.x, lane = tid & 63, wave = tid >> 6;
    LAS float* AT = (LAS float*)lds;
    LAS float* ST = (LAS float*)(lds + 24576);
    const float* mod = (const float*)(a.ws + WS_MOD);
    for (int idx = tid; idx < 3 * 2048; idx += 512) { const int m = idx >> 11, c = idx & 2047;
        ST[idx] = mod[m * 6144 + c]; AT[idx] = a.in[8][c] * (1.0f + mod[m * 6144 + 2048 + c]); }
    __syncthreads();
    bf16_t* H = (bf16_t*)a.out;
    const int gw = blockIdx.x * 8 + wave, NGW = gridDim.x * 8;
    f32x4 vn[8];
    { const int row = gw; const float* xr = row < M_CTX ? a.in[0] + (size_t)row * DM : a.in[1] + (size_t)(row - M_CTX) * DM;
#pragma unroll
      for (int j = 0; j < 8; ++j) vn[j] = __builtin_nontemporal_load((const f32x4*)(xr + 4 * lane + 256 * j)); }
#pragma unroll 1
    for (int row = gw; row < M_ALL; row += NGW) {
        const int m = row < M_CTX ? 0 : 1 + ((row - M_CTX) >> 12);
        f32x4 v[8]; float ss = 0.f;
#pragma unroll
        for (int j = 0; j < 8; ++j) { v[j] = vn[j]; ss += (v[j].x * v[j].x + v[j].y * v[j].y) + (v[j].z * v[j].z + v[j].w * v[j].w); }
        if (row + NGW < M_ALL) { const int rn = row + NGW; const float* xr = rn < M_CTX ? a.in[0] + (size_t)rn * DM : a.in[1] + (size_t)(rn - M_CTX) * DM;
#pragma unroll
            for (int j = 0; j < 8; ++j) vn[j] = __builtin_nontemporal_load((const f32x4*)(xr + 4 * lane + 256 * j)); }
        const float rstd = 1.0f / sqrtf(wave_sum(ss) * (1.0f / DM) + EPS);
#pragma unroll
        for (int j = 0; j < 8; ++j) { const f32x4 av = *(const LAS f32x4*)(AT + m * 2048 + 4 * lane + 256 * j), sv = *(const LAS f32x4*)(ST + m * 2048 + 4 * lane + 256 * j);
            const f32x4 hv = v[j] * rstd * av + sv; u32x2 o; o.x = cvtpk(hv.x, hv.y); o.y = cvtpk(hv.z, hv.w);
            *(u32x2*)(H + (size_t)row * DM + 4 * lane + 256 * j) = o; }
    }
}

__device__ __forceinline__ bf16_t* slotp(const Args& a, int s) { return (bf16_t*)(a.ws + WS_PROJ + (size_t)s * SLOT); }
__device__ __forceinline__ bf16_t* obase(const Args& a, int dir, int lat) {
    bf16_t* o = (bf16_t*)a.out;
    return lat ? o + (size_t)2 * M_CTX * DM + (size_t)dir * (M_ALL - M_CTX) * DM - (size_t)M_CTX * DM : o + (size_t)dir * M_CTX * DM;
}
__device__ __forceinline__ float* xs_row(const Args& a, int row) {
    return row < M_CTX ? (float*)(a.ws + WS_PROJ + (size_t)(row >> 10) * SLOT + (size_t)(row & 1023) * 8192) : (float*)(a.ws + WS_XS) + (size_t)row * DM;
}
__device__ __forceinline__ void phase3(const Args& a, LAS unsigned char* lds) {
    const int tid = threadIdx.x;
    {
        const int sub = tid >> 8, dir = (tid >> 7) & 1, d = tid & 127;
        const float* LB = (const float*)(a.ws + WS_LB); float* EV = (float*)(a.ws + WS_EVEC);
        u32x4 pre[12];
#define P3_LOAD(p_) do { const int cg_ = (p_) >> 2, hp_ = (p_) & 3; \
            _Pragma("unroll") for (int u_ = 0; u_ < 12; ++u_) { const int n_ = tid + 512 * u_, tile_ = n_ >> 10, row_ = (n_ >> 4) & 63, ch_ = n_ & 15; const int sb_ = tile_ / 3, kind_ = tile_ % 3; \
                pre[u_] = *(const u32x4*)(slotp(a, 4 + kind_) + pk_off(cg_ * 64 + row_, (2 * hp_ + sb_) * 128 + ch_ * 8)); } } while (0)
        int p = blockIdx.x;
        if (p < 768) P3_LOAD(p);
        for (; p < 768; p += gridDim.x) {
            const int h = 2 * (p & 3) + sub, cgi = p >> 2, col = h * 128 + d;
            BAR_LDS();
#pragma unroll
            for (int u = 0; u < 12; ++u) *(LAS u32x4*)(lds + 16 * (tid + 512 * u)) = pre[u];
            BAR_LDS();
            if (p + (int)gridDim.x < 768) P3_LOAD(p + (int)gridDim.x);
            const LAS bf16_t* qt = (const LAS bf16_t*)(lds + (sub * 3 + 0) * 16384) + d;
            LAS bf16_t* zt = (LAS bf16_t*)(lds + (sub * 3 + 1 + dir) * 16384) + d;
            bf16_t* qo = slotp(a, 9 + dir) + pk_off(cgi * 64, col);
            const float lb = LB[dir * 1024 + col]; float b = 0.f;
#pragma unroll 1
            for (int i0 = 0; i0 < 64; i0 += 16) {
                float zz[16], qq[16], ff[16], bb[16];
#pragma unroll
                for (int u = 0; u < 16; ++u) { const int r = dir ? 63 - (i0 + u) : (i0 + u); zz[u] = bf2f(zt[r * 128]); qq[u] = bf2f(qt[r * 128]); }
#pragma unroll
                for (int u = 0; u < 16; ++u) { const float sg = __builtin_amdgcn_rcpf(1.0f + __builtin_amdgcn_exp2f(-1.4426950408889634f * zz[u])); ff[u] = lb + (1.0f - lb) * sg; bb[u] = __builtin_amdgcn_logf(ff[u]); }
#pragma unroll
                for (int u = 0; u < 16; ++u) { b += bb[u]; bb[u] = b; }
#pragma unroll
                for (int u = 0; u < 16; ++u) { const int r = dir ? 63 - (i0 + u) : (i0 + u);
                    const float eb = __builtin_amdgcn_exp2f(bb[u]), ieb = __builtin_amdgcn_exp2f(-bb[u]);
                    qo[(size_t)r * 128] = (bf16_t)(cvtpk(qq[u] * eb, 0.f) & 0xffffu); zt[r * 128] = (bf16_t)(cvtpk((1.0f - ff[u]) * ieb, 0.f) & 0xffffu); }
            }
            EV[((size_t)(cgi * 8 + h) * 2 + dir) * 128 + d] = __builtin_amdgcn_exp2f(b);
            BAR_LDS();
#pragma unroll
            for (int u = 0; u < 8; ++u) { const int n = tid + 512 * u, t4 = n >> 10, row = (n >> 4) & 63, ch = n & 15; const int sb = t4 >> 1, dr = t4 & 1;
                const u32x4 v = *(const LAS u32x4*)(lds + (sb * 3 + 1 + dr) * 16384 + row * 256 + ch * 16);
                *(u32x4*)(slotp(a, 5 + dr) + pk_off(cgi * 64 + row, (2 * (p & 3) + sb) * 128 + ch * 8)) = v; }
        }
#undef P3_LOAD
        BAR_LDS();
    }
}

__device__ __forceinline__ unsigned off_b(unsigned row, unsigned ch) { return 256u * row + 16u * (ch ^ (((row & 3) << 2) | ((row >> 2) & 3))); }
__device__ __forceinline__ unsigned tr_addr(unsigned lane, unsigned c, unsigned ks, unsigned t) {
    const unsigned h = lane >> 5, blk = (lane >> 4) & 1, q = (lane & 15) >> 2, p = lane & 3;
    return off_b(16 * ks + 8 * h + 4 * t + q, 4 * c + 2 * blk + (p >> 1)) + 8 * (p & 1);
}
__device__ __forceinline__ unsigned pt_off(unsigned i, unsigned ch) { return 128u * i + 16u * (ch ^ ((i >> 1) & 7)); }
template <bool WAIT = true> __device__ __forceinline__ void tr_frag4(unsigned base, unsigned lane, unsigned c, bf16x8 (&f)[4]) {
    s16x4 r0, r1, r2, r3, r4, r5, r6, r7;
    const unsigned a0 = base + tr_addr(lane, c, 0, 0), a1 = base + tr_addr(lane, c, 0, 1);
    if (WAIT) asm volatile("ds_read_b64_tr_b16 %0, %8\n\tds_read_b64_tr_b16 %1, %9\n\tds_read_b64_tr_b16 %2, %8 offset:4096\n\tds_read_b64_tr_b16 %3, %9 offset:4096\n\t"
                 "ds_read_b64_tr_b16 %4, %8 offset:8192\n\tds_read_b64_tr_b16 %5, %9 offset:8192\n\tds_read_b64_tr_b16 %6, %8 offset:12288\n\tds_read_b64_tr_b16 %7, %9 offset:12288\n\ts_waitcnt lgkmcnt(0)"
                 : "=&v"(r0), "=&v"(r1), "=&v"(r2), "=&v"(r3), "=&v"(r4), "=&v"(r5), "=&v"(r6), "=&v"(r7)
                 : "v"(a0), "v"(a1) : "memory");
    else asm volatile("ds_read_b64_tr_b16 %0, %8\n\tds_read_b64_tr_b16 %1, %9\n\tds_read_b64_tr_b16 %2, %8 offset:4096\n\tds_read_b64_tr_b16 %3, %9 offset:4096\n\t"
                 "ds_read_b64_tr_b16 %4, %8 offset:8192\n\tds_read_b64_tr_b16 %5, %9 offset:8192\n\tds_read_b64_tr_b16 %6, %8 offset:12288\n\tds_read_b64_tr_b16 %7, %9 offset:12288"
                 : "=&v"(r0), "=&v"(r1), "=&v"(r2), "=&v"(r3), "=&v"(r4), "=&v"(r5), "=&v"(r6), "=&v"(r7)
                 : "v"(a0), "v"(a1) : "memory");
    f[0] = __builtin_shufflevector(r0, r1, 0, 1, 2, 3, 4, 5, 6, 7); f[1] = __builtin_shufflevector(r2, r3, 0, 1, 2, 3, 4, 5, 6, 7);
    f[2] = __builtin_shufflevector(r4, r5, 0, 1, 2, 3, 4, 5, 6, 7); f[3] = __builtin_shufflevector(r6, r7, 0, 1, 2, 3, 4, 5, 6, 7);
}
template <bool WAIT = true> __device__ __forceinline__ void tr_frag8(unsigned base, unsigned lane, unsigned c, bf16x8 (&f)[4], bf16x8 (&g)[4]) {
    s16x4 r0, r1, r2, r3, r4, r5, r6, r7, q0, q1, q2, q3, q4, q5, q6, q7;
    const unsigned a0 = base + tr_addr(lane, c, 0, 0), a1 = base + tr_addr(lane, c, 0, 1), b0 = base + tr_addr(lane, c + 1, 0, 0), b1 = base + tr_addr(lane, c + 1, 0, 1);
    if (WAIT) asm volatile("ds_read_b64_tr_b16 %0, %16\n\tds_read_b64_tr_b16 %1, %17\n\tds_read_b64_tr_b16 %2, %16 offset:4096\n\tds_read_b64_tr_b16 %3, %17 offset:4096\n\t"
                 "ds_read_b64_tr_b16 %4, %16 offset:8192\n\tds_read_b64_tr_b16 %5, %17 offset:8192\n\tds_read_b64_tr_b16 %6, %16 offset:12288\n\tds_read_b64_tr_b16 %7, %17 offset:12288\n\t"
                 "ds_read_b64_tr_b16 %8, %18\n\tds_read_b64_tr_b16 %9, %19\n\tds_read_b64_tr_b16 %10, %18 offset:4096\n\tds_read_b64_tr_b16 %11, %19 offset:4096\n\t"
                 "ds_read_b64_tr_b16 %12, %18 offset:8192\n\tds_read_b64_tr_b16 %13, %19 offset:8192\n\tds_read_b64_tr_b16 %14, %18 offset:12288\n\tds_read_b64_tr_b16 %15, %19 offset:12288\n\ts_waitcnt lgkmcnt(0)"
                 : "=&v"(r0), "=&v"(r1), "=&v"(r2), "=&v"(r3), "=&v"(r4), "=&v"(r5), "=&v"(r6), "=&v"(r7), "=&v"(q0), "=&v"(q1), "=&v"(q2), "=&v"(q3), "=&v"(q4), "=&v"(q5), "=&v"(q6), "=&v"(q7)
                 : "v"(a0), "v"(a1), "v"(b0), "v"(b1) : "memory");
    else asm volatile("ds_read_b64_tr_b16 %0, %16\n\tds_read_b64_tr_b16 %1, %17\n\tds_read_b64_tr_b16 %2, %16 offset:4096\n\tds_read_b64_tr_b16 %3, %17 offset:4096\n\t"
                 "ds_read_b64_tr_b16 %4, %16 offset:8192\n\tds_read_b64_tr_b16 %5, %17 offset:8192\n\tds_read_b64_tr_b16 %6, %16 offset:12288\n\tds_read_b64_tr_b16 %7, %17 offset:12288\n\t"
                 "ds_read_b64_tr_b16 %8, %18\n\tds_read_b64_tr_b16 %9, %19\n\tds_read_b64_tr_b16 %10, %18 offset:4096\n\tds_read_b64_tr_b16 %11, %19 offset:4096\n\t"
                 "ds_read_b64_tr_b16 %12, %18 offset:8192\n\tds_read_b64_tr_b16 %13, %19 offset:8192\n\tds_read_b64_tr_b16 %14, %18 offset:12288\n\tds_read_b64_tr_b16 %15, %19 offset:12288"
                 : "=&v"(r0), "=&v"(r1), "=&v"(r2), "=&v"(r3), "=&v"(r4), "=&v"(r5), "=&v"(r6), "=&v"(r7), "=&v"(q0), "=&v"(q1), "=&v"(q2), "=&v"(q3), "=&v"(q4), "=&v"(q5), "=&v"(q6), "=&v"(q7)
                 : "v"(a0), "v"(a1), "v"(b0), "v"(b1) : "memory");
    f[0] = __builtin_shufflevector(r0, r1, 0, 1, 2, 3, 4, 5, 6, 7); f[1] = __builtin_shufflevector(r2, r3, 0, 1, 2, 3, 4, 5, 6, 7);
    f[2] = __builtin_shufflevector(r4, r5, 0, 1, 2, 3, 4, 5, 6, 7); f[3] = __builtin_shufflevector(r6, r7, 0, 1, 2, 3, 4, 5, 6, 7);
    g[0] = __builtin_shufflevector(q0, q1, 0, 1, 2, 3, 4, 5, 6, 7); g[1] = __builtin_shufflevector(q2, q3, 0, 1, 2, 3, 4, 5, 6, 7);
    g[2] = __builtin_shufflevector(q4, q5, 0, 1, 2, 3, 4, 5, 6, 7); g[3] = __builtin_shufflevector(q6, q7, 0, 1, 2, 3, 4, 5, 6, 7);
}
template <bool WAIT> __device__ __forceinline__ void lds_rd8(const unsigned (&ad)[8], bf16x8 (&f)[8]) {
    if (WAIT) asm volatile("ds_read_b128 %0, %8\n\tds_read_b128 %1, %9\n\tds_read_b128 %2, %10\n\tds_read_b128 %3, %11\n\tds_read_b128 %4, %12\n\tds_read_b128 %5, %13\n\tds_read_b128 %6, %14\n\tds_read_b128 %7, %15\n\ts_waitcnt lgkmcnt(0)"
                 : "=&v"(f[0]), "=&v"(f[1]), "=&v"(f[2]), "=&v"(f[3]), "=&v"(f[4]), "=&v"(f[5]), "=&v"(f[6]), "=&v"(f[7])
                 : "v"(ad[0]), "v"(ad[1]), "v"(ad[2]), "v"(ad[3]), "v"(ad[4]), "v"(ad[5]), "v"(ad[6]), "v"(ad[7]) : "memory");
    else asm volatile("ds_read_b128 %0, %8\n\tds_read_b128 %1, %9\n\tds_read_b128 %2, %10\n\tds_read_b128 %3, %11\n\tds_read_b128 %4, %12\n\tds_read_b128 %5, %13\n\tds_read_b128 %6, %14\n\tds_read_b128 %7, %15"
                 : "=&v"(f[0]), "=&v"(f[1]), "=&v"(f[2]), "=&v"(f[3]), "=&v"(f[4]), "=&v"(f[5]), "=&v"(f[6]), "=&v"(f[7])
                 : "v"(ad[0]), "v"(ad[1]), "v"(ad[2]), "v"(ad[3]), "v"(ad[4]), "v"(ad[5]), "v"(ad[6]), "v"(ad[7]) : "memory");
}
template <bool WAIT> __device__ __forceinline__ void lds_rd4(const unsigned (&ad)[4], bf16x8 (&f)[4]) {
    if (WAIT) asm volatile("ds_read_b128 %0, %4\n\tds_read_b128 %1, %5\n\tds_read_b128 %2, %6\n\tds_read_b128 %3, %7\n\ts_waitcnt lgkmcnt(0)"
                 : "=&v"(f[0]), "=&v"(f[1]), "=&v"(f[2]), "=&v"(f[3]) : "v"(ad[0]), "v"(ad[1]), "v"(ad[2]), "v"(ad[3]) : "memory");
    else asm volatile("ds_read_b128 %0, %4\n\tds_read_b128 %1, %5\n\tds_read_b128 %2, %6\n\tds_read_b128 %3, %7"
                 : "=&v"(f[0]), "=&v"(f[1]), "=&v"(f[2]), "=&v"(f[3]) : "v"(ad[0]), "v"(ad[1]), "v"(ad[2]), "v"(ad[3]) : "memory");
}
#define LGKM_WAIT_SCHED() do { asm volatile("s_waitcnt lgkmcnt(0)" ::: "memory"); __builtin_amdgcn_sched_barrier(0); } while (0)
__device__ __forceinline__ u32x4 scale_bf8(u32x4 x, float f) {
    u32x4 o;
#pragma unroll
    for (int e = 0; e < 4; ++e) o[e] = cvtpk(bflo(x[e]) * f, bfhi(x[e]) * f);
    return o;
}

constexpr unsigned L_T = 49152, L_QT = 0, L_KT = 16384, L_VT = 32768, L_SI = 98304, L_PT = 131072, L_PTSZ = 8192, L_EV = 147456, L_EVSZ = 512, L_DUMMY = 149504;

__device__ __forceinline__ void chain_item(const Args& a, LAS unsigned char* lds, int grp, int b, int h, int type, int dir) {
    const int tid = threadIdx.x, lane = tid & 63, w = __builtin_amdgcn_readfirstlane(tid >> 6), r = lane & 31, hh = lane >> 5;
    const unsigned lbase = (unsigned)(size_t)lds;
    const int nch = grp ? 64 : 4, rowbase = grp ? M_CTX + b * 4096 : b * 256;
    const bf16_t* qs = type ? slotp(a, 9 + dir) : slotp(a, 0);
    const bf16_t* ks_ = type ? slotp(a, 5 + dir) : slotp(a, 1);
    const bf16_t* vs = type ? slotp(a, 7) : slotp(a, 2);
    const float* EVg = (const float*)(a.ws + WS_EVEC);
    bf16_t* odir = obase(a, dir, grp);
    const float lg = type ? 0.f : ((const float*)(a.ws + WS_LG))[dir * 8 + h];
    const float sdec = __expf(lg * 64.0f);
    const int lrow0 = tid >> 4, lch = tid & 15;
    const size_t gcol = (size_t)h * 128 + lch * 8;
    const int vt = w & 3, it = w >> 2, dh = w >> 2;
    float pfac = 1.f, kfac0 = 1.f, kfac1 = 1.f, qfac0 = 1.f, qfac1 = 1.f;
    if (!type) { pfac = __expf(-lg * 64.0f);
        kfac0 = __expf(lg * (float)(dir ? lrow0 : 63 - lrow0)); kfac1 = __expf(lg * (float)(dir ? lrow0 + 32 : 31 - lrow0));
        qfac0 = __expf(lg * (float)(dir ? 64 - lrow0 : lrow0 + 1)); qfac1 = __expf(lg * (float)(dir ? 32 - lrow0 : lrow0 + 33)); }
    f32x16 S0, S1;
    if (grp) { const float* s0 = a.in[2 + type * 2 + dir] + (size_t)(b * 8 + h) * 16384;
#pragma unroll
        for (int t = 0; t < 16; ++t) { const int dd = (t & 3) + 8 * (t >> 2) + 4 * hh;
            S0[t] = s0[(size_t)(64 * dh + dd) * 128 + 32 * vt + r]; S1[t] = s0[(size_t)(64 * dh + 32 + dd) * 128 + 32 * vt + r]; } }
    else {
#pragma unroll
        for (int t = 0; t < 16; ++t) { S0[t] = 0.f; S1[t] = 0.f; } }
    u32x4 pq[2], pk[2]; float pe = 0.f;
#define CH_IDX(n) (dir ? nch - 1 - (n) : (n))
#define CH_LOAD(n) do { const int c__ = CH_IDX(n); const size_t rb_ = pk_off(rowbase + 64 * c__, h * 128) + (size_t)lch * 8; \
        _Pragma("unroll") for (int u_ = 0; u_ < 2; ++u_) { const size_t o_ = rb_ + (size_t)(lrow0 + 32 * u_) * 128; \
            pq[u_] = *(const u32x4*)(qs + o_); pk[u_] = *(const u32x4*)(ks_ + o_); } \
        if (type && tid < 128) pe = EVg[((size_t)(((rowbase >> 6) + c__) * 8 + h) * 2 + dir) * 128 + tid]; } while (0)
#define CH_STORE(TB, EB) do { \
        _Pragma("unroll") for (int u_ = 0; u_ < 2; ++u_) { const int row_ = lrow0 + 32 * u_; const unsigned o_ = (TB) + off_b(row_, lch); \
            u32x4 kk_ = pk[u_], qq_ = pq[u_]; if (!type) { kk_ = scale_bf8(kk_, u_ ? kfac1 : kfac0); qq_ = scale_bf8(qq_, u_ ? qfac1 : qfac0); } \
            *(LAS u32x4*)(lds + L_QT + o_) = qq_; *(LAS u32x4*)(lds + L_KT + o_) = kk_; } \
        if (type && tid < 128) *(LAS float*)(lds + L_EV + (EB) + 4 * tid) = pe; } while (0)
#define SI_STORE() do { \
        _Pragma("unroll") for (int g_ = 0; g_ < 4; ++g_) { \
            u32x2 x0_, x1_; x0_.x = cvtpk(S0[4 * g_], S0[4 * g_ + 1]); x0_.y = cvtpk(S0[4 * g_ + 2], S0[4 * g_ + 3]); x1_.x = cvtpk(S1[4 * g_], S1[4 * g_ + 1]); x1_.y = cvtpk(S1[4 * g_ + 2], S1[4 * g_ + 3]); \
            *(LAS u32x2*)(lds + L_SI + off_b(32 * vt + r, 4 * (2 * dh) + g_) + 8 * hh) = x0_; *(LAS u32x2*)(lds + L_SI + off_b(32 * vt + r, 4 * (2 * dh + 1) + g_) + 8 * hh) = x1_; } } while (0)
#define CH_VDMA(n, TB) do { const int c__ = CH_IDX(n); const bf16_t* vb_ = vs + pk_off(rowbase + 64 * c__, h * 128); \
        _Pragma("unroll") for (int u_ = 0; u_ < 2; ++u_) { const int p_ = w + 8 * u_, row_ = 4 * p_ + (lane >> 4), cst_ = lane & 15; \
            const int ch_ = cst_ ^ (((row_ & 3) << 2) | ((row_ >> 2) & 3)); \
            const bf16_t* src_ = vb_ + row_ * 128 + ch_ * 8; \
            const unsigned dst_ = (unsigned)__builtin_amdgcn_readfirstlane((int)(lbase + L_VT + (TB) + 1024u * (unsigned)p_)); \
            asm volatile("s_mov_b32 m0, %1\n\ts_nop 0\n\tglobal_load_lds_dwordx4 %0, off" :: "v"(src_), "s"(dst_) : "memory", "m0"); } } while (0)
#define CH_SCORES(LB, TB, PB) do { if (w < 4) { \
            const int jt_ = w >> 1, it2_ = w & 1; \
            f32x16 acc_; \
            _Pragma("unroll") for (int t_ = 0; t_ < 16; ++t_) acc_[t_] = 0.f; \
            { const unsigned oa_ = off_b(32 * jt_ + r, hh), ob_ = off_b(32 * it2_ + r, hh); \
              _Pragma("unroll") for (int hf_ = 0; hf_ < 2; ++hf_) { bf16x8 fx_[8]; unsigned ax_[8]; \
                _Pragma("unroll") for (int s_ = 0; s_ < 4; ++s_) { ax_[s_] = (LB) + L_KT + (TB) + (oa_ ^ (32u * (4 * hf_ + s_))); ax_[4 + s_] = (LB) + L_QT + (TB) + (ob_ ^ (32u * (4 * hf_ + s_))); } \
                lds_rd8<true>(ax_, fx_); \
                __builtin_amdgcn_sched_barrier(0); \
                _Pragma("unroll") for (int s_ = 0; s_ < 4; ++s_) acc_ = MFMA32(fx_[s_], fx_[4 + s_], acc_); \
                __builtin_amdgcn_sched_barrier(0); } } \
            const int i_ = 32 * it2_ + r; \
            _Pragma("unroll") for (int g_ = 0; g_ < 4; ++g_) { float x_[4]; \
                _Pragma("unroll") for (int e_ = 0; e_ < 4; ++e_) { const int j_ = 32 * jt_ + 8 * g_ + 4 * hh + e_; const bool keep_ = dir ? (j_ >= i_) : (i_ >= j_); x_[e_] = keep_ ? acc_[4 * g_ + e_] * pfac : 0.f; } \
                u32x2 o_; o_.x = cvtpk(x_[0], x_[1]); o_.y = cvtpk(x_[2], x_[3]); \
                *(LAS u32x2*)(lds + L_PT + (PB) + pt_off(i_, 4 * jt_ + g_) + 8 * hh) = o_; } } } while (0)

    BAR_LDS();
    CH_VDMA(0, 0u); CH_VDMA(1, L_T);
    CH_LOAD(0);
    CH_STORE(0u, 0u); SI_STORE();
    CH_LOAD(1);
    BAR_LDS();
    CH_SCORES(lbase, 0u, 0u);
    CH_STORE(L_T, L_EVSZ);
    if (2 < nch) CH_LOAD(2);
    BAR_LDS();
#pragma unroll 1
    for (int step = 0; step < nch; ++step) {
        unsigned zv; asm volatile("v_mov_b32 %0, 0" : "=v"(zv));
        const unsigned lb2 = lbase + zv;
        const unsigned par = (unsigned)(step & 1), tcur = par * L_T, tnxt = L_T - tcur, pcur = par * L_PTSZ, pnxt = L_PTSZ - pcur, ecur = par * L_EVSZ;
        const int row0 = rowbase + 64 * CH_IDX(step);
#ifdef PROBE_SLEEP
        __builtin_amdgcn_s_sleep(PROBE_SLEEP);
#endif
        if (step + 1 < nch) CH_SCORES(lb2, tnxt, pnxt);
        {
            bf16x8 vf_[4], kf_[4], kg_[4];
            const unsigned os0 = off_b(32 * vt + r, hh), oq0 = off_b(32 * it + r, hh), op0 = pt_off(32 * it + r, hh);
            __builtin_amdgcn_sched_barrier(0);
            tr_frag4<false>(lb2 + L_VT + tcur, lane, vt, vf_);
            tr_frag8<true>(lb2 + L_KT + tcur, lane, 2 * dh, kf_, kg_);
            __builtin_amdgcn_sched_barrier(0);
            bf16x8 pb_[4];
            { unsigned ap_[4];
#pragma unroll
              for (int s2 = 0; s2 < 4; ++s2) ap_[s2] = lb2 + L_PT + pcur + (op0 ^ (32u * s2));
              lds_rd4<false>(ap_, pb_); }
            __builtin_amdgcn_sched_barrier(0);
            if (!type) {
#pragma unroll
                for (int t = 0; t < 16; ++t) { S0[t] *= sdec; S1[t] *= sdec; } }
#pragma unroll
            for (int s2 = 0; s2 < 4; ++s2) { S0 = MFMA32(kf_[s2], vf_[s2], S0); S1 = MFMA32(kg_[s2], vf_[s2], S1); }
            __builtin_amdgcn_sched_barrier(0);
            f32x16 o1_;
#pragma unroll
            for (int t = 0; t < 16; ++t) o1_[t] = 0.f;
            { bf16x8 sq_[8]; unsigned asq_[8];
#pragma unroll
              for (int s2 = 0; s2 < 4; ++s2) { asq_[s2] = lb2 + L_SI + (os0 ^ (32u * s2)); asq_[4 + s2] = lb2 + L_QT + tcur + (oq0 ^ (32u * s2)); }
              lds_rd8<true>(asq_, sq_);
              __builtin_amdgcn_sched_barrier(0);
#pragma unroll
              for (int s2 = 0; s2 < 4; ++s2) { o1_ = MFMA32(pb_[s2], vf_[s2], o1_); o1_ = MFMA32(sq_[4 + s2], sq_[s2], o1_); } }
            __builtin_amdgcn_sched_barrier(0);
            { bf16x8 sq2_[8]; unsigned asq_[8];
#pragma unroll
              for (int s2 = 0; s2 < 4; ++s2) { asq_[s2] = lb2 + L_SI + (os0 ^ (32u * (s2 + 4))); asq_[4 + s2] = lb2 + L_QT + tcur + (oq0 ^ (32u * (s2 + 4))); }
              lds_rd8<true>(asq_, sq2_);
              __builtin_amdgcn_sched_barrier(0);
  #pragma unroll
              for (int s2 = 0; s2 < 4; ++s2) o1_ = MFMA32(sq2_[4 + s2], sq2_[s2], o1_); }
            __builtin_amdgcn_sched_barrier(0);
            if (type) {
#pragma unroll
                for (int g = 0; g < 4; ++g) { const f32x4 e0_ = *(const LAS f32x4*)(lds + L_EV + ecur + 4 * (64 * dh + 8 * g + 4 * hh)), e1_ = *(const LAS f32x4*)(lds + L_EV + ecur + 4 * (64 * dh + 32 + 8 * g + 4 * hh));
#pragma unroll
                    for (int e = 0; e < 4; ++e) { S0[4 * g + e] *= e0_[e]; S1[4 * g + e] *= e1_[e]; } } }
            bf16_t* op_ = odir + pk2_off(row0 + 32 * it + 4 * hh, type * 1024 + h * 128 + 32 * vt + r);
#pragma unroll
            for (int t = 0; t < 16; ++t) op_[((t & 3) + 8 * (t >> 2)) * 128] = (bf16_t)(cvtpk(o1_[t], 0.f) & 0xffffu);
        }
        BAR_LDS();
        SI_STORE();
        if (step + 2 < nch) CH_STORE(tcur, ecur);
        if (step + 2 < nch) CH_VDMA(step + 2, tcur);
        if (step + 3 < nch) CH_LOAD(step + 3);
        else if (step + 1 < nch) asm volatile("s_waitcnt vmcnt(0)" ::: "memory");
        BAR_LDS();
    }
    if (!grp) {
        float* so = a.out + (size_t)M_ALL * DM + (size_t)(type * 2 + dir) * (16 * 8 * 16384) + (size_t)(b * 8 + h) * 16384;
#pragma unroll
        for (int t = 0; t < 16; ++t) { const int dd = (t & 3) + 8 * (t >> 2) + 4 * hh;
            so[(size_t)(64 * dh + dd) * 128 + 32 * vt + r] = S0[t]; so[(size_t)(64 * dh + 32 + dd) * 128 + 32 * vt + r] = S1[t]; }
    }
#undef CH_IDX
#undef CH_VDMA
#undef CH_LOAD
#undef CH_STORE
#undef SI_STORE
#undef CH_SCORES
}
__device__ __forceinline__ void p4b_finish(const Args& a, bf16_t* om, int idx, u32x4 xf, u32x4 xb, u32x4 gg) {
    const int l16 = idx & 15, seg = (idx >> 4) & 15, row = idx >> 8, type = seg >> 3;
    const size_t off = (size_t)row * DM + seg * 128 + l16 * 8;
    float o[8]; float ss = 0.f;
#pragma unroll
    for (int e = 0; e < 4; ++e) { o[2 * e] = bflo(xf[e]) + bflo(xb[e]); o[2 * e + 1] = bfhi(xf[e]) + bfhi(xb[e]); ss += o[2 * e] * o[2 * e] + o[2 * e + 1] * o[2 * e + 1]; }
    ss += __shfl_xor(ss, 1); ss += __shfl_xor(ss, 2); ss += __shfl_xor(ss, 4); ss += __shfl_xor(ss, 8);
    const float rstd = 1.0f / sqrtf(ss * (1.0f / 128.0f) + EPS);
    float wv[8];
    if (type) { const f32x4 w0 = *(const f32x4*)(a.in[14] + l16 * 8), w1 = *(const f32x4*)(a.in[14] + l16 * 8 + 4);
        wv[0] = w0.x; wv[1] = w0.y; wv[2] = w0.z; wv[3] = w0.w; wv[4] = w1.x; wv[5] = w1.y; wv[6] = w1.z; wv[7] = w1.w; }
    else {
#pragma unroll
        for (int e = 0; e < 8; ++e) wv[e] = 1.0f; }
    u32x4 res;
#pragma unroll
    for (int e = 0; e < 4; ++e) { const float g0 = bflo(gg[e]), g1 = bfhi(gg[e]);
        const float s0 = g0 * __builtin_amdgcn_rcpf(1.0f + __expf(-g0)), s1 = g1 * __builtin_amdgcn_rcpf(1.0f + __expf(-g1));
        res[e] = cvtpk(o[2 * e] * rstd * wv[2 * e] * s0, o[2 * e + 1] * rstd * wv[2 * e + 1] * s1); }
    *(u32x4*)(om + off) = res;
}
__device__ __forceinline__ void phase4b(const Args& a, int row_lo, int row_hi, int wblk, int nblk) {
    const int NT = nblk * 512;
    const bf16_t* of = obase(a, 0, row_lo >= M_CTX); const bf16_t* ob = obase(a, 1, row_lo >= M_CTX);
    bf16_t* om = (bf16_t*)(a.ws + WS_OMIX);
    const int end = row_hi * 256;
#define P4B_LOAD(IDX, XF, XB, GG) do { const int l16_ = (IDX) & 15, seg_ = ((IDX) >> 4) & 15, row_ = (IDX) >> 8; const size_t off_ = (size_t)row_ * DM + seg_ * 128 + l16_ * 8; \
        const size_t offp_ = pk2_off(row_, seg_ * 128 + l16_ * 8); XF = *(const u32x4*)(of + offp_); XB = *(const u32x4*)(ob + offp_); GG = *(const u32x4*)(slotp(a, (seg_ >> 3) ? 8 : 3) + pk_off(row_, (seg_ & 7) * 128 + l16_ * 8)); } while (0)
    int idx = row_lo * 256 + wblk * 512 + threadIdx.x;
    for (; idx + NT < end; idx += 2 * NT) {
        u32x4 xf0, xb0, gg0, xf1, xb1, gg1;
        P4B_LOAD(idx, xf0, xb0, gg0); P4B_LOAD(idx + NT, xf1, xb1, gg1);
        p4b_finish(a, om, idx, xf0, xb0, gg0); p4b_finish(a, om, idx + NT, xf1, xb1, gg1);
    }
    if (idx < end) { u32x4 xf0, xb0, gg0; P4B_LOAD(idx, xf0, xb0, gg0); p4b_finish(a, om, idx, xf0, xb0, gg0); }
#undef P4B_LOAD
}

struct EpiProj {
    static constexpr bool PERM = true, AFTER_DRAIN = false;
    bf16_t* O; const LAS float* RT;
    __device__ __forceinline__ void operator()(const pg8::f32x4 (&acc)[2][2][4][2], const pg8::Unit& u, int wr, int wc, int fr, int fq) const {
        const int row0 = u.pm * 256 + wr * 64 + fr; const int slot = u.pn >> 2, colt = (u.pn & 3) * 256;
        bf16_t* base = O + (size_t)slot * ((size_t)M_ALL * 1024);
        if (u.pn >= 8) {
            const int col0 = colt + wc * 32 + 8 * fq;
#pragma unroll
            for (int ai = 0; ai < 2; ++ai)
#pragma unroll
                for (int mm = 0; mm < 4; ++mm) { bf16_t* rowp = base + pk_off(row0 + ai * 128 + mm * 16, col0);
#pragma unroll
                    for (int bj = 0; bj < 2; ++bj) { const pg8::f32x4 v0 = acc[ai][bj][mm][0], v1 = acc[ai][bj][mm][1];
                        u32x4 wv; wv.x = cvtpk(v0[0], v0[1]); wv.y = cvtpk(v0[2], v0[3]); wv.z = cvtpk(v1[0], v1[1]); wv.w = cvtpk(v1[2], v1[3]);
                        *(u32x4*)(rowp + bj * 8192) = wv; } }
        } else {
            const int part = wc >> 1, j0 = 4 * (4 * (wc & 1) + fq);
            const int lcol = colt + 64 * part + j0;
#pragma unroll
            for (int ai = 0; ai < 2; ++ai)
#pragma unroll
                for (int mm = 0; mm < 4; ++mm) { const int rr = row0 + ai * 128 + mm * 16; bf16_t* rowp = base + pk_off(rr, lcol);
                    pg8::f32x4 ca = {1.f, 0.f, 1.f, 0.f}, cb = ca;
                    if (rr >= M_CTX) { const int t = (rr - M_CTX) & 4095, pos = part ? (t & 63) : (t >> 6); const LAS float* cs = RT + (pos * 32 + j0) * 2;
                        ca = *(const LAS pg8::f32x4*)cs; cb = *(const LAS pg8::f32x4*)(cs + 4); }
#pragma unroll
                    for (int bj = 0; bj < 2; ++bj) { const pg8::f32x4 x1 = acc[ai][bj][mm][0], x2 = acc[ai][bj][mm][1];
                        u32x2 o1, o2;
                        o1.x = cvtpk(x1[0] * ca[0] - x2[0] * ca[1], x1[1] * ca[2] - x2[1] * ca[3]); o1.y = cvtpk(x1[2] * cb[0] - x2[2] * cb[1], x1[3] * cb[2] - x2[3] * cb[3]);
                        o2.x = cvtpk(x1[0] * ca[1] + x2[0] * ca[0], x1[1] * ca[3] + x2[1] * ca[2]); o2.y = cvtpk(x1[2] * cb[1] + x2[2] * cb[0], x1[3] * cb[3] + x2[3] * cb[2]);
                        *(u32x2*)(rowp + bj * 8192) = o1; *(u32x2*)(rowp + bj * 8192 + 32) = o2; } }
        }
    }
};

struct EpiResNorm {
    static constexpr bool PERM = false, AFTER_DRAIN = true;
    const float* xp; const float* xsm; float* y; const float* gate; const float* fw; unsigned* xch; unsigned* cnt; int row_off;
    __device__ __forceinline__ void fused(pg8::f32x4 (&acc)[2][2][4][2], const pg8::Unit& u, int wr, int wc, int fr, int fq, LAS unsigned char* lds, int wid, int lane) const {
        const int prow0 = row_off + u.pm * 256, panel = prow0 >> 8;
        const int m = (prow0 < M_CTX) ? 0 : 1 + ((prow0 - M_CTX) >> 12);
        const int col0 = u.pn * 256 + wc * 32 + 4 * fq;
        LAS float* P = (LAS float*)lds;
        LAS float* R = (LAS float*)(lds + 4096);
        pg8::f32x4 gv[2][2];
#pragma unroll
        for (int bj = 0; bj < 2; ++bj)
#pragma unroll
            for (int n = 0; n < 2; ++n) gv[bj][n] = *(const pg8::f32x4*)(gate + m * 2048 + col0 + bj * 128 + n * 16);
#pragma unroll
        for (int ai = 0; ai < 2; ++ai)
#pragma unroll
            for (int mm = 0; mm < 4; ++mm) { const int r = ai * 128 + wr * 64 + mm * 16 + fr, rr = prow0 + r;
                const float* xr = (rr < M_CTX ? xp + (size_t)rr * DM : xsm + (size_t)(rr - M_CTX) * DM) + col0; float sq = 0.f;
#pragma unroll
                for (int bj = 0; bj < 2; ++bj)
#pragma unroll
                    for (int n = 0; n < 2; ++n) { const pg8::f32x4 xv = *(const pg8::f32x4*)(xr + bj * 128 + n * 16); const pg8::f32x4 v = xv + gv[bj][n] * acc[ai][bj][mm][n];
                        acc[ai][bj][mm][n] = v; sq += (v[0] * v[0] + v[1] * v[1]) + (v[2] * v[2] + v[3] * v[3]); }
                sq += __shfl_xor(sq, 16); sq += __shfl_xor(sq, 32);
                if (fq == 0) P[r * 4 + wc] = sq;
                asm volatile("" : "+v"(acc[ai][0][mm][0]), "+v"(acc[ai][0][mm][1]), "+v"(acc[ai][1][mm][0]), "+v"(acc[ai][1][mm][1]));
                if (mm & 1) asm volatile("" ::: "memory"); }
        asm volatile("s_waitcnt lgkmcnt(0)" ::: "memory"); __builtin_amdgcn_s_barrier(); asm volatile("" ::: "memory");
        const int row = wid * 32 + (lane & 31);
        if (lane < 32) { const float t = (P[row * 4 + 0] + P[row * 4 + 1]) + (P[row * 4 + 2] + P[row * 4 + 3]);
            __hip_atomic_store(xch + (size_t)(prow0 + row) * 8 + u.pn, __float_as_uint(t), __ATOMIC_RELAXED, __HIP_MEMORY_SCOPE_AGENT); }
        asm volatile("s_waitcnt vmcnt(0)" ::: "memory");
        if (lane == 0) __hip_atomic_fetch_add(cnt + 64 * panel, 1u, __ATOMIC_RELAXED, __HIP_MEMORY_SCOPE_AGENT);
        if (wid == 0) { unsigned sp = 0u;
            while ((unsigned)__builtin_amdgcn_readfirstlane(__hip_atomic_load(cnt + 64 * panel, __ATOMIC_RELAXED, __HIP_MEMORY_SCOPE_AGENT)) < 64u) { __builtin_amdgcn_s_sleep(2); if (++sp > (1u << 22)) break; }
            __builtin_amdgcn_fence(__ATOMIC_ACQUIRE, "agent"); }
        asm volatile("s_waitcnt vmcnt(0) lgkmcnt(0)" ::: "memory"); __builtin_amdgcn_s_barrier(); asm volatile("" ::: "memory");
        if (lane < 32) { const unsigned* sl = xch + (size_t)(prow0 + row) * 8; float t = 0.f;
#pragma unroll
            for (int k = 0; k < 8; ++k) t += __uint_as_float(__hip_atomic_load(sl + k, __ATOMIC_RELAXED, __HIP_MEMORY_SCOPE_AGENT));
            R[row] = 1.0f / sqrtf(t * (1.0f / DM) + EPS); }
        asm volatile("s_waitcnt lgkmcnt(0)" ::: "memory"); __builtin_amdgcn_s_barrier(); asm volatile("" ::: "memory");
        pg8::f32x4 wv[2][2];
#pragma unroll
        for (int bj = 0; bj < 2; ++bj)
#pragma unroll
            for (int n = 0; n < 2; ++n) wv[bj][n] = *(const pg8::f32x4*)(fw + col0 + bj * 128 + n * 16);
#pragma unroll
        for (int ai = 0; ai < 2; ++ai)
#pragma unroll
            for (int mm = 0; mm < 4; ++mm) { const int r = ai * 128 + wr * 64 + mm * 16 + fr; const float rs = R[r]; float* yr = y + (size_t)(prow0 + r) * DM + col0;
#pragma unroll
                for (int bj = 0; bj < 2; ++bj)
#pragma unroll
                    for (int n = 0; n < 2; ++n) *(pg8::f32x4*)(yr + bj * 128 + n * 16) = acc[ai][bj][mm][n] * rs * wv[bj][n]; }
    }
};

__global__ void __launch_bounds__(512, 2) hybrid_fwd(Args a) {
    extern __shared__ __attribute__((aligned(16))) unsigned char lds_raw[];
    LAS unsigned char* lds = (LAS unsigned char*)lds_raw;
    cg::grid_group grid = cg::this_grid();
    volatile LAS unsigned* xst = (volatile LAS unsigned*)(lds + LDS_BYTES - 64);
    if (threadIdx.x < 4) xst[threadIdx.x] = 0u;
    __syncthreads();
#define GSYNC() xcd_barrier(xbar)
#ifdef PROBE_SEG
#define TS(i) do { if (blockIdx.x == 0 && threadIdx.x == 0) ((volatile LAS unsigned long long*)(lds + LDS_BYTES - 512))[i] = __builtin_amdgcn_s_memrealtime(); } while (0)
#else
#define TS(i) do { } while (0)
#endif

#define DO_P2() do {     \
        pg8::Gemm g{(const pg8::bf16_t*)a.out, (const pg8::bf16_t*)(a.ws + WS_WINT), M_ALL, NIN, DM}; \
        pg8::StaticOrder S; S.init(M_ALL, NIN, (int)gridDim.x, (int)blockIdx.x); \
        EpiProj E{(bf16_t*)(a.ws + WS_PROJ), (const LAS float*)(lds + 131072)}; \
        pg8::gemm_phase<EpiProj, pg8::StaticOrder>(lds, g, S, E, nullptr); \
        GSYNC(); } while (0)
    TS(0);
    const XcdBarrier xbar = xcd_barrier_post((unsigned*)(a.ws + WS_BAR), xst, (unsigned)gridDim.x);
    XcdBarrier cbar = xbar;
    if (blockIdx.x >= 64) cbar = xcd_barrier_post((unsigned*)(a.ws + WS_BAR2), xst + 2, (unsigned)gridDim.x - 64u);
    if (a.ws == nullptr) grid.sync();
    phase0(a, lds); GSYNC(); TS(1);
    phase0b(a); GSYNC(); TS(2);
#if REP_P0 > 1
    phase0(a, lds); GSYNC();
#endif
    phase1(a, lds); GSYNC(); TS(3);
#if REP_P1 > 1
    phase1(a, lds); GSYNC();
#endif
    { const f32x4* src = (const f32x4*)(a.ws + WS_ROPE); LAS f32x4* dst = (LAS f32x4*)(lds + 131072);
      for (int i = threadIdx.x; i < 1024; i += 512) dst[i] = src[i]; }
    __syncthreads();
    DO_P2(); TS(4);
#if REP_P2 > 1
    DO_P2();
#endif
    phase3(a, lds); GSYNC(); TS(5);
#define DO_P5N(ROW0, MROWS, GSUB, CSUB) do {     \
        pg8::Gemm g{(const pg8::bf16_t*)(a.ws + WS_OMIX) + (size_t)(ROW0) * DM, (const pg8::bf16_t*)(a.ws + WS_WOUTT), (MROWS), DM, DM}; \
        pg8::StaticOrder S; S.init((MROWS), DM, (GSUB), (CSUB)); \
        EpiResNorm E{a.in[0], a.in[1], a.out, (const float*)(a.ws + WS_GATE), a.in[16], (unsigned*)(a.ws + WS_XCH), (unsigned*)(a.ws + WS_PCNT), (ROW0)}; \
        pg8::gemm_phase<EpiResNorm, pg8::StaticOrder>(lds, g, S, E, nullptr); } while (0)
    const int G = gridDim.x, bx = blockIdx.x;
    {
        const int cb = bx - 64, ncb = G - 64; unsigned sgen = 0u; unsigned* scnt = (unsigned*)(a.ws + WS_BAR) + 3520;
#pragma unroll 1
        for (int k = 0; k < (bx < 64 ? REP_LAT : 8); ++k) { const int L = bx < 64 ? bx : bx + k * ncb; if (L >= 576) break;
            const int grp = L < 64 ? 1 : 0, ci = grp ? L : L - 64;
            chain_item(a, lds, grp, ci >> 5, (ci >> 2) & 7, (ci >> 1) & 1, ci & 1); }
        if (bx >= 64) {
            xcd_barrier(cbar);
            phase4b(a, 0, M_CTX, cb, ncb);
            xcd_barrier(cbar);
            DO_P5N(0, M_CTX, ncb, cb);
        }
        TS(6);
        GSYNC(); TS(7);
        phase4b(a, M_CTX, M_ALL, bx, G); GSYNC(); TS(8);
        DO_P5N(M_CTX, M_ALL - M_CTX, G, bx);
        TS(9);
#ifdef PROBE_SEG
        if (blockIdx.x == 0 && threadIdx.x == 0) { volatile LAS unsigned long long* ts = (volatile LAS unsigned long long*)(lds + LDS_BYTES - 512);
            const unsigned long long d = (PROBE_SEG == 99) ? ts[9] - ts[0] : ts[(PROBE_SEG % 16) + 1] - ts[PROBE_SEG % 16], t0 = __builtin_amdgcn_s_memrealtime();
            while (__builtin_amdgcn_s_memrealtime() - t0 < (unsigned long long)PROBE_MULT * d) __builtin_amdgcn_s_sleep(8); }
#endif
#ifdef REP_SYNC
#pragma unroll 1
        for (int rep = 0; rep < REP_SYNC; ++rep) GSYNC();
#endif
    }
}

extern "C" void kernel_launch(void* const* d_in, const int* in_sizes, int n_in, void* d_out, int out_size, void* d_ws, size_t ws_size, hipStream_t stream) {
    static int grid = 0;
    if (grid == 0) {
        if (n_in != 17 || ws_size < WS_END) { fprintf(stderr, "kernel_launch: needs 17 inputs and %zu bytes of workspace (got %d, %zu)\n", (size_t)WS_END, n_in, ws_size); grid = -1; return; }
        int dev = 0, cus = 0, per_cu = 0;
        hipGetDevice(&dev); hipDeviceGetAttribute(&cus, hipDeviceAttributeMultiprocessorCount, dev);
        if (hipFuncSetAttribute((const void*)hybrid_fwd, hipFuncAttributeMaxDynamicSharedMemorySize, LDS_BYTES) != hipSuccess) { fprintf(stderr, "kernel_launch: hipFuncSetAttribute failed\n"); grid = -1; return; }
        if (hipOccupancyMaxActiveBlocksPerMultiprocessor(&per_cu, (const void*)hybrid_fwd, 512, LDS_BYTES) != hipSuccess || per_cu < 1) per_cu = 1;
        (void)hipGetLastError();
        grid = cus * per_cu;
        if (grid != 256) { fprintf(stderr, "kernel_launch: built for a 256-workgroup grid (256 CUs x 1), got %d\n", grid); grid = -1; return; }
    }
    if (grid < 0) return;
    Args a{};
    for (int i = 0; i < 17; ++i) a.in[i] = (const float*)d_in[i];
    a.out = (float*)d_out; a.ws = (unsigned char*)d_ws;
    if (hipMemsetAsync((char*)d_ws + WS_BAR, 0, 16384 + 48 * 256 + 16384, stream) != hipSuccess) { fprintf(stderr, "kernel_launch: memset of barrier words failed\n"); return; }
    void* args[] = {&a};
    hipError_t e = hipLaunchCooperativeKernel((const void*)hybrid_fwd, dim3(grid), dim3(512), args, LDS_BYTES, stream);
    if (e != hipSuccess) fprintf(stderr, "cooperative launch failed: %s (grid %d)\n", hipGetErrorString(e), grid);
}
```

```cpp
#include <hip/hip_runtime.h>
#include <hip/hip_cooperative_groups.h>
#include <cstdio>
namespace pg8 {
#define PG8_LAS __attribute__((address_space(3)))
typedef unsigned short bf16_t;
typedef short bf16x8 __attribute__((ext_vector_type(8)));
typedef float f32x4 __attribute__((ext_vector_type(4)));
typedef unsigned u32x4 __attribute__((ext_vector_type(4)));
constexpr int BM = 256, BK = 64, HALF = 128, HTB = HALF * BK * 2  , STAGE_BYTES = 8 * HTB, NXCD = 8, WGM = 8;

__host__ __device__ __forceinline__ int lds_byte(int r, int c) { const int st = (r >> 4) * 2 + (c >> 5), rr = r & 15, cc = c & 31, ob = rr * 64 + cc * 2; return st * 1024 + (ob ^ (((ob >> 9) & 1) << 5)); }
__host__ __device__ __forceinline__ void stage_rc(int b, int& R, int& C) { const int st = b / 1024, sb = b % 1024, swz = sb ^ (((sb >> 9) & 1) << 5); R = (st >> 1) * 16 + swz / 64; C = (st & 1) * 32 + (swz % 64) / 2; }
__host__ __device__ __forceinline__ int perm32(int rho) { const int n = rho >> 4, i = rho & 15; return 8 * (i >> 2) + 4 * n + (i & 3); }

struct Unit { int pm, pn; };
struct Gemm { const bf16_t* A; const bf16_t* Bt; int M, N, K; };

struct StaticOrder {
    int nM, nN, nwg, G, c;
    __host__ __device__ void init(int M, int N, int G_, int c_) { nM = M / BM; nN = N / BM; nwg = nM * nN; G = G_; c = c_; }
    __host__ __device__ bool next(int i, Unit& u) const {
        const long L = (long)i * G + c; if (L >= nwg) return false;
        int wgid = (int)L; { const int q = nwg / NXCD, r = nwg % NXCD, xcd = wgid % NXCD, off = wgid / NXCD; wgid = (xcd < r ? xcd * (q + 1) : r * (q + 1) + (xcd - r) * q) + off; }
        const int nig = WGM * nN, gid = wgid / nig, fm = gid * WGM, gsz = (nM - fm) < WGM ? (nM - fm) : WGM;
        u.pm = fm + ((wgid % nig) % gsz); u.pn = (wgid % nig) / gsz; return true;
    }
    __device__ __forceinline__ void a_ready(const Unit&) const {}
    __device__ __forceinline__ void done(const Unit&) const {}
};
struct CountedOrder : StaticOrder {
    const unsigned* ready; unsigned need; unsigned* tmo;
    __device__ __forceinline__ void a_ready(const Unit& u) const {
        if (threadIdx.x < 64) {
            const unsigned long long t0 = __builtin_amdgcn_s_memrealtime(); unsigned polls = 0;
            while ((unsigned)__builtin_amdgcn_readfirstlane(__hip_atomic_load(ready + 64 * u.pm, __ATOMIC_RELAXED, __HIP_MEMORY_SCOPE_AGENT)) < need) {
                if ((++polls & 255u) == 0u && __builtin_amdgcn_readfirstlane(__hip_atomic_load(tmo, __ATOMIC_RELAXED, __HIP_MEMORY_SCOPE_AGENT)) != 0u) break;
                if (__builtin_amdgcn_s_memrealtime() - t0 > 2000000ull) {
                    if (threadIdx.x == 0) { unsigned expect = 0u; __hip_atomic_compare_exchange_strong(tmo + 1, &expect, 0x600u | (unsigned)(u.pm & 0xff), __ATOMIC_RELAXED, __ATOMIC_RELAXED, __HIP_MEMORY_SCOPE_AGENT); __hip_atomic_store(tmo, 1u, __ATOMIC_RELAXED, __HIP_MEMORY_SCOPE_AGENT); }
                    break; }
                __builtin_amdgcn_s_sleep(2); }
            __builtin_amdgcn_fence(__ATOMIC_ACQUIRE, "agent");
            asm volatile("s_waitcnt vmcnt(0)" ::: "memory");
        }
#if !defined(BROKEN_HOOK_NO_BARRIER)
        asm volatile("" ::: "memory"); __builtin_amdgcn_s_barrier(); asm volatile("" ::: "memory");
#endif
    }
};

__device__ __forceinline__ unsigned cvt_pk_bf16(float lo, float hi) { unsigned r; asm volatile("v_cvt_pk_bf16_f32 %0, %1, %2" : "=v"(r) : "v"(lo), "v"(hi)); return r; }
typedef float f32x2 __attribute__((ext_vector_type(2)));
__device__ __forceinline__ f32x2 gelu_pk(f32x2 v) {
    const f32x2 av = __builtin_elementwise_abs(v), d = av * 0.2316418882f + 1.0f;
    f32x2 t; t.x = __builtin_amdgcn_rcpf(d.x); t.y = __builtin_amdgcn_rcpf(d.y);
    f32x2 q = t * 0.5307027145f + (-0.7265760135f); q = q * t + 0.7107068705f; q = q * t + (-0.142248368f); q = q * t + 0.127414796f; q = q * t;
    const f32x2 s = (v * v) * (-0.72134752044f);
    f32x2 e; e.x = __builtin_amdgcn_exp2f(s.x); e.y = __builtin_amdgcn_exp2f(s.y);
    const f32x2 m = v * (q * e), r = v - m;
    f32x2 o; o.x = v.x < 0.f ? m.x : r.x; o.y = v.y < 0.f ? m.y : r.y; return o;
}

struct EpiF32 {
    static constexpr bool PERM = false, AFTER_DRAIN = false;
    float* C; int ldc; const float* bias;
    __device__ __forceinline__ void operator()(const f32x4 (&acc)[2][2][4][2], const Unit& u, int wr, int wc, int fr, int fq) const {
        const int row0 = u.pm * BM + wr * 64 + fr, col0 = u.pn * BM + wc * 32 + 4 * fq;
        f32x4 bv[2][2];
#pragma unroll
        for (int bj = 0; bj < 2; ++bj)
#pragma unroll
            for (int n = 0; n < 2; ++n) bv[bj][n] = bias ? *(const f32x4*)(bias + col0 + bj * HALF + n * 16) : (f32x4){0.f, 0.f, 0.f, 0.f};
#pragma unroll
        for (int ai = 0; ai < 2; ++ai)
#pragma unroll
            for (int m = 0; m < 4; ++m) { float* rowp = C + (size_t)(row0 + ai * HALF + m * 16) * ldc + col0;
#pragma unroll
                for (int bj = 0; bj < 2; ++bj)
#pragma unroll
                    for (int n = 0; n < 2; ++n) *(f32x4*)(rowp + bj * HALF + n * 16) = acc[ai][bj][m][n] + bv[bj][n]; }
    }
};
template <int ACT  > struct EpiBf16 {
    static constexpr bool PERM = true, AFTER_DRAIN = false;
    bf16_t* O; int ldc; const float* bias; int split_cols; size_t split_stride;
    __device__ __forceinline__ void operator()(const f32x4 (&acc)[2][2][4][2], const Unit& u, int wr, int wc, int fr, int fq) const {
        const int row0 = u.pm * BM + wr * 64 + fr; int colt = u.pn * BM; bf16_t* base = O;
        if (split_cols) { const int t = colt / split_cols; base += (size_t)t * split_stride; colt -= t * split_cols; }
        const int col0 = colt + wc * 32 + 8 * fq, bcol0 = u.pn * BM + wc * 32 + 8 * fq;
        f32x4 bv[2][2];
#pragma unroll
        for (int bj = 0; bj < 2; ++bj)
#pragma unroll
            for (int n = 0; n < 2; ++n) bv[bj][n] = bias ? *(const f32x4*)(bias + bcol0 + bj * HALF + 4 * n) : (f32x4){0.f, 0.f, 0.f, 0.f};
#pragma unroll
        for (int ai = 0; ai < 2; ++ai)
#pragma unroll
            for (int m = 0; m < 4; ++m) { bf16_t* rowp = base + (size_t)(row0 + ai * HALF + m * 16) * ldc + col0;
#pragma unroll
                for (int bj = 0; bj < 2; ++bj) { f32x4 v0 = acc[ai][bj][m][0] + bv[bj][0], v1 = acc[ai][bj][m][1] + bv[bj][1];
                    if (ACT == 1) { f32x2 a = gelu_pk((f32x2){v0[0], v0[1]}), b = gelu_pk((f32x2){v0[2], v0[3]}), c = gelu_pk((f32x2){v1[0], v1[1]}), d = gelu_pk((f32x2){v1[2], v1[3]});
                        v0 = (f32x4){a.x, a.y, b.x, b.y}; v1 = (f32x4){c.x, c.y, d.x, d.y}; }
                    if (ACT == 2) {
#pragma unroll
                        for (int j = 0; j < 4; ++j) { v0[j] = 0.5f * v0[j] * (1.0f + erff(v0[j] * 0.70710678f)); v1[j] = 0.5f * v1[j] * (1.0f + erff(v1[j] * 0.70710678f)); } }
                    u32x4 w; w.x = cvt_pk_bf16(v0[0], v0[1]); w.y = cvt_pk_bf16(v0[2], v0[3]); w.z = cvt_pk_bf16(v1[0], v1[1]); w.w = cvt_pk_bf16(v1[2], v1[3]);
                    *(u32x4*)(rowp + bj * HALF) = w; } }
    }
};

struct PanelStats {
    unsigned* xbuf;
    unsigned* cnt;
    unsigned* tmo;
    int ntn; float eps;
    unsigned code;
    __device__ __forceinline__ bool run(const f32x4 (&v)[2][2][4][2], const Unit& u, int wr, int wc, int fr, int fq, PG8_LAS unsigned char* lds, int wid, int lane) const {
        typedef float f32x2v __attribute__((ext_vector_type(2)));
        PG8_LAS f32x2v* P = (PG8_LAS f32x2v*)lds;
        PG8_LAS f32x2v* S = (PG8_LAS f32x2v*)(lds + 8192);
        PG8_LAS unsigned* flag = (PG8_LAS unsigned*)(lds + 8192 + 2048);
#pragma unroll
        for (int ai = 0; ai < 2; ++ai)
#pragma unroll
            for (int m = 0; m < 4; ++m) {
                float s = 0.f;
#pragma unroll
                for (int bj = 0; bj < 2; ++bj)
#pragma unroll
                    for (int n = 0; n < 2; ++n) { const f32x4 x = v[ai][bj][m][n]; s += (x[0] + x[1]) + (x[2] + x[3]); }
                s += __shfl_xor(s, 16); s += __shfl_xor(s, 32);
                const float mw = s * (1.0f / 64.0f); float q = 0.f;
#pragma unroll
                for (int bj = 0; bj < 2; ++bj)
#pragma unroll
                    for (int n = 0; n < 2; ++n) { const f32x4 d = v[ai][bj][m][n] - mw; q += (d[0] * d[0] + d[1] * d[1]) + (d[2] * d[2] + d[3] * d[3]); }
                q += __shfl_xor(q, 16); q += __shfl_xor(q, 32);
                if (fq == 0) P[(ai * HALF + wr * 64 + m * 16 + fr) * 4 + wc] = (f32x2v){mw, q};
            }
        asm volatile("s_waitcnt lgkmcnt(0)" ::: "memory"); __builtin_amdgcn_s_barrier(); asm volatile("" ::: "memory");
#if defined(BROKEN_NO_WAIT)
        if (blockIdx.x >= 64) { const long long t0 = clock64(); while (clock64() - t0 < 60000) __builtin_amdgcn_s_sleep(8); }
#endif
        const int row = wid * 32 + (lane & 31);
        if (lane < 32) {
            const f32x2v a = P[row * 4 + 0], b = P[row * 4 + 1], c = P[row * 4 + 2], d = P[row * 4 + 3];
            const float mt = (a.x + b.x + c.x + d.x) * 0.25f;
            const float da = a.x - mt, db = b.x - mt, dc = c.x - mt, dd = d.x - mt;
            const float m2 = (a.y + b.y) + (c.y + d.y) + 64.0f * ((da * da + db * db) + (dc * dc + dd * dd));
            unsigned long long* slot = (unsigned long long*)xbuf + ((size_t)(u.pm * BM + row) * 4 + u.pn);
            __hip_atomic_store(slot, ((unsigned long long)__float_as_uint(m2) << 32) | __float_as_uint(mt), __ATOMIC_RELAXED, __HIP_MEMORY_SCOPE_AGENT);
        }
        asm volatile("s_waitcnt vmcnt(0)" ::: "memory");
        if (lane == 0) __hip_atomic_fetch_add(cnt + 64 * u.pm, 1u, __ATOMIC_RELAXED, __HIP_MEMORY_SCOPE_AGENT);
        if (wid == 0) {
            bool dead = false; const unsigned long long t0 = __builtin_amdgcn_s_memrealtime(); const unsigned want = 8u * (unsigned)ntn;
            for (;;) {
#if defined(BROKEN_NO_WAIT)
                break;
#endif
                if ((unsigned)__builtin_amdgcn_readfirstlane(__hip_atomic_load(cnt + 64 * u.pm, __ATOMIC_RELAXED, __HIP_MEMORY_SCOPE_AGENT)) >= want) break;
                if (__builtin_amdgcn_s_memrealtime() - t0 > 2000000ull) {
                    if (lane == 0) { unsigned expect = 0u; __hip_atomic_compare_exchange_strong(tmo + 1, &expect, code | (unsigned)(u.pm & 0xff), __ATOMIC_RELAXED, __ATOMIC_RELAXED, __HIP_MEMORY_SCOPE_AGENT);
                                     __hip_atomic_store(tmo, 1u, __ATOMIC_RELAXED, __HIP_MEMORY_SCOPE_AGENT); }
                    dead = true; break; }
                __builtin_amdgcn_s_sleep(2);
            }
            __builtin_amdgcn_fence(__ATOMIC_ACQUIRE, "agent");
            if (lane == 0) flag[0] = dead ? 1u : 0u;
        }
        asm volatile("s_waitcnt vmcnt(0) lgkmcnt(0)" ::: "memory"); __builtin_amdgcn_s_barrier(); asm volatile("" ::: "memory");
        const bool bad = flag[0] != 0u;
        if (lane < 32) {
            const unsigned long long* slot = (const unsigned long long*)xbuf + (size_t)(u.pm * BM + row) * 4; float mt[4], m2[4]; float ms = 0.f;
#pragma unroll
            for (int t = 0; t < 4; ++t) { if (t < ntn) { const unsigned long long w = __hip_atomic_load(slot + t, __ATOMIC_RELAXED, __HIP_MEMORY_SCOPE_AGENT); mt[t] = __uint_as_float((unsigned)w); m2[t] = __uint_as_float((unsigned)(w >> 32)); } else { mt[t] = 0.f; m2[t] = 0.f; } ms += mt[t]; }
            const float mean = ms / (float)ntn; float q = 0.f;
#pragma unroll
            for (int t = 0; t < 4; ++t) if (t < ntn) { const float dm = mt[t] - mean; q += m2[t] + 256.0f * dm * dm; }
            S[row] = (f32x2v){mean, 1.0f / sqrtf(q / (256.0f * (float)ntn) + eps)};
        }
        asm volatile("s_waitcnt lgkmcnt(0)" ::: "memory"); __builtin_amdgcn_s_barrier(); asm volatile("" ::: "memory");
        return bad;
    }
};
struct EpiLnRes {
    static constexpr bool PERM = false, AFTER_DRAIN = true;
    const float* base; float* out; int ldc; const float* bias; PanelStats st; unsigned poison;
    __device__ __forceinline__ void refuse(size_t i0, size_t stride, int M, int N) const { const float q = __builtin_nanf(""); for (size_t i = i0; i < (size_t)M * N; i += stride) out[(i / N) * ldc + i % N] = q;
        if (i0 == 0) { unsigned expect = 0u; __hip_atomic_compare_exchange_strong(st.tmo + 1, &expect, 0x7f0u, __ATOMIC_RELAXED, __ATOMIC_RELAXED, __HIP_MEMORY_SCOPE_AGENT); __hip_atomic_store(st.tmo, 1u, __ATOMIC_RELAXED, __HIP_MEMORY_SCOPE_AGENT); } }
    __device__ __forceinline__ void fused(f32x4 (&acc)[2][2][4][2], const Unit& u, int wr, int wc, int fr, int fq, PG8_LAS unsigned char* lds, int wid, int lane) const {
        typedef float f32x2v __attribute__((ext_vector_type(2)));
        const PG8_LAS f32x2v* S = (const PG8_LAS f32x2v*)(lds + 8192);
        const int col0 = u.pn * BM + wc * 32 + 4 * fq;
#pragma unroll
        for (int bj = 0; bj < 2; ++bj)
#pragma unroll
            for (int n = 0; n < 2; ++n) { const f32x4 bv = bias ? *(const f32x4*)(bias + col0 + bj * HALF + n * 16) : (f32x4){0.f, 0.f, 0.f, 0.f};
#pragma unroll
                for (int ai = 0; ai < 2; ++ai)
#pragma unroll
                    for (int m = 0; m < 4; ++m) acc[ai][bj][m][n] += bv; }
        const bool bad = st.run(acc, u, wr, wc, fr, fq, lds, wid, lane) || poison != 0u;
        const float qnan = __builtin_nanf("");
#pragma unroll
        for (int ai = 0; ai < 2; ++ai)
#pragma unroll
            for (int m = 0; m < 4; ++m) { const int r = ai * HALF + wr * 64 + m * 16 + fr; const f32x2v sr = S[r]; const size_t off = (size_t)(u.pm * BM + r) * ldc + col0;
#pragma unroll
                for (int bj = 0; bj < 2; ++bj)
#pragma unroll
                    for (int n = 0; n < 2; ++n) { const f32x4 bs = *(const f32x4*)(base + off + bj * HALF + n * 16); f32x4 o = bs + (acc[ai][bj][m][n] - sr.x) * sr.y;
                        if (bad) o = (f32x4){qnan, qnan, qnan, qnan}; *(f32x4*)(out + off + bj * HALF + n * 16) = o; }
                asm volatile("" ::: "memory"); }
    }
};
struct EpiLnResLn {
    static constexpr bool PERM = false, AFTER_DRAIN = true;
    const float* base; float* out; bf16_t* xn; int ldc; const float* bias; PanelStats st1, st2; unsigned poison;
    __device__ __forceinline__ void refuse(size_t i0, size_t stride, int M, int N) const { const float q = __builtin_nanf(""); for (size_t i = i0; i < (size_t)M * N; i += stride) { const size_t o = (i / N) * ldc + i % N; out[o] = q; xn[o] = (bf16_t)0x7fc0u; }
        if (i0 == 0) { unsigned expect = 0u; __hip_atomic_compare_exchange_strong(st1.tmo + 1, &expect, 0x7f0u, __ATOMIC_RELAXED, __ATOMIC_RELAXED, __HIP_MEMORY_SCOPE_AGENT); __hip_atomic_store(st1.tmo, 1u, __ATOMIC_RELAXED, __HIP_MEMORY_SCOPE_AGENT); } }
    __device__ __forceinline__ void fused(f32x4 (&acc)[2][2][4][2], const Unit& u, int wr, int wc, int fr, int fq, PG8_LAS unsigned char* lds, int wid, int lane) const {
        typedef float f32x2v __attribute__((ext_vector_type(2))); typedef unsigned u32x2v __attribute__((ext_vector_type(2)));
        const PG8_LAS f32x2v* S = (const PG8_LAS f32x2v*)(lds + 8192);
        const int col0 = u.pn * BM + wc * 32 + 4 * fq;
#pragma unroll
        for (int bj = 0; bj < 2; ++bj)
#pragma unroll
            for (int n = 0; n < 2; ++n) { const f32x4 bv = bias ? *(const f32x4*)(bias + col0 + bj * HALF + n * 16) : (f32x4){0.f, 0.f, 0.f, 0.f};
#pragma unroll
                for (int ai = 0; ai < 2; ++ai)
#pragma unroll
                    for (int m = 0; m < 4; ++m) acc[ai][bj][m][n] += bv; }
        bool bad = st1.run(acc, u, wr, wc, fr, fq, lds, wid, lane) || poison != 0u;
        const float qnan = __builtin_nanf("");
#pragma unroll
        for (int ai = 0; ai < 2; ++ai)
#pragma unroll
            for (int m = 0; m < 4; ++m) { const int r = ai * HALF + wr * 64 + m * 16 + fr; const f32x2v sr = S[r]; const size_t off = (size_t)(u.pm * BM + r) * ldc + col0;
#pragma unroll
                for (int bj = 0; bj < 2; ++bj)
#pragma unroll
                    for (int n = 0; n < 2; ++n) { const f32x4 bs = *(const f32x4*)(base + off + bj * HALF + n * 16); acc[ai][bj][m][n] = bs + (acc[ai][bj][m][n] - sr.x) * sr.y; }
                asm volatile("" : "+v"(acc[ai][0][m][0]), "+v"(acc[ai][0][m][1]), "+v"(acc[ai][1][m][0]), "+v"(acc[ai][1][m][1]));
                if (m & 1) asm volatile("" ::: "memory"); }
        const bool bad1 = bad;
        bad = st2.run(acc, u, wr, wc, fr, fq, lds, wid, lane) || bad;
#pragma unroll
        for (int ai = 0; ai < 2; ++ai)
#pragma unroll
            for (int m = 0; m < 4; ++m) { const int r = ai * HALF + wr * 64 + m * 16 + fr; const f32x2v sr = S[r]; const size_t off = (size_t)(u.pm * BM + r) * ldc + col0;
#pragma unroll
                for (int bj = 0; bj < 2; ++bj)
#pragma unroll
                    for (int n = 0; n < 2; ++n) { const f32x4 x1 = acc[ai][bj][m][n]; *(f32x4*)(out + off + bj * HALF + n * 16) = bad1 ? (f32x4){qnan, qnan, qnan, qnan} : x1;
                        const f32x4 o = (x1 - sr.x) * sr.y; u32x2v w; w.x = cvt_pk_bf16(o[0], o[1]); w.y = cvt_pk_bf16(o[2], o[3]);
                        if (bad) { w.x = 0x7fc07fc0u; w.y = 0x7fc07fc0u; } *(u32x2v*)(xn + off + bj * HALF + n * 16) = w; }
                asm volatile("" ::: "memory"); }
    }
};

template <class Epi, class Sched, bool STAMP = false>
__device__ __forceinline__ void gemm_phase(PG8_LAS unsigned char* lds, const Gemm g, const Sched& S, const Epi& E, unsigned long long* stamps) {
    int tid_ = threadIdx.x; asm volatile("" : "+v"(tid_));
    const int tid = tid_, wid = __builtin_amdgcn_readfirstlane(tid >> 6), lane = tid & 63, wr = wid >> 2, wc = wid & 3, fr = lane & 15, fq = lane >> 4;
    const int K = g.K, nt = K / BK;
    int ts_lo = 0, ts_hi = 0, nts = 0; const unsigned long long rt_entry = STAMP ? (unsigned long long)wall_clock64() : 0ull;
#define PG8_STAMP() do { if (STAMP && wid == 0 && nts < 64) { const unsigned long long _c = (unsigned long long)clock64(); \
        ts_lo = (lane == nts) ? (int)(unsigned)_c : ts_lo; ts_hi = (lane == nts) ? (int)(unsigned)(_c >> 32) : ts_hi; ++nts; } } while (0)
    PG8_STAMP();
    unsigned voffA[2], voffB[2];
#pragma unroll
    for (int i = 0; i < 2; ++i) { int R, C; stage_rc(tid * 16 + i * 8192, R, C); const int Rb = Epi::PERM ? ((R & ~31) + perm32(R & 31)) : R;
        voffA[i] = (unsigned)(R * K + C) * 2u; voffB[i] = (unsigned)(Rb * K + C) * 2u; }
    const size_t kstep = (size_t)(BK * 2);
    const size_t hstep = (size_t)HALF * K * 2;
    const size_t tstep = 2 * hstep;
    const unsigned ldsw = (unsigned)wid * 1024u;
    const int aoff = lds_byte(wr * 64 + fr, fq * 8), boff = lds_byte(wc * 32 + fr, fq * 8);
#define PG8_SA(b, h) (((b) * 2 + (h)) * HTB)
#define PG8_SB(b, h) ((4 + (b) * 2 + (h)) * HTB)
#define PG8_STAGE(bufoff, gbase, voff) do { _Pragma("unroll") for (int _i = 0; _i < 2; ++_i) \
        __builtin_amdgcn_global_load_lds((const unsigned*)((const char*)(gbase) + (voff)[_i]), (PG8_LAS unsigned*)(lds + (bufoff) + ldsw + _i * 8192), 16, 0, 0); } while (0)
#define PG8_LDA(dst, b, h) do { _Pragma("unroll") for (int m = 0; m < 4; ++m) _Pragma("unroll") for (int k = 0; k < 2; ++k) dst[m][k] = *(const PG8_LAS bf16x8*)(lds + PG8_SA(b, h) + aoff + m * 2048 + k * 1024); } while (0)
#define PG8_LDB(dst, b, h) do { _Pragma("unroll") for (int n = 0; n < 2; ++n) _Pragma("unroll") for (int k = 0; k < 2; ++k) dst[n][k] = *(const PG8_LAS bf16x8*)(lds + PG8_SB(b, h) + boff + n * 2048 + k * 1024); } while (0)
#define PG8_MMA(ai, bj, At, Bt) do { __builtin_amdgcn_s_setprio(1); _Pragma("unroll") for (int m = 0; m < 4; ++m) _Pragma("unroll") for (int n = 0; n < 2; ++n) _Pragma("unroll") for (int k = 0; k < 2; ++k) \
        acc[ai][bj][m][n] = __builtin_amdgcn_mfma_f32_16x16x32_bf16(Bt[n][k], At[m][k], acc[ai][bj][m][n], 0, 0, 0); __builtin_amdgcn_s_setprio(0); } while (0)
#define PG8_WAIT_V(n) asm volatile("s_waitcnt vmcnt(" #n ")" ::: "memory")
#define PG8_WAIT_L(n) asm volatile("s_waitcnt lgkmcnt(" #n ")" ::: "memory")
#define PG8_BAR __builtin_amdgcn_s_barrier()
#define PG8_SCHED __builtin_amdgcn_sched_barrier(0)
    Unit cur, nxt; int ui = 0;
    if (!S.next(0, cur)) return;
    f32x4 acc[2][2][4][2];
#pragma unroll
    for (int a = 0; a < 2; ++a)
#pragma unroll
        for (int b = 0; b < 2; ++b)
#pragma unroll
            for (int m = 0; m < 4; ++m)
#pragma unroll
                for (int n = 0; n < 2; ++n) acc[a][b][m][n] = (f32x4){0.f, 0.f, 0.f, 0.f};
    bf16x8 At[4][2], B0[2][2], B1[2][2];
    const char* cA = (const char*)g.A + (size_t)cur.pm * tstep; const char* cB = (const char*)g.Bt + (size_t)cur.pn * tstep;
    S.a_ready(cur);
    PG8_STAGE(PG8_SB(0, 0), cB, voffB); PG8_STAGE(PG8_SA(0, 0), cA, voffA); PG8_STAGE(PG8_SB(0, 1), cB + hstep, voffB); PG8_STAGE(PG8_SA(0, 1), cA + hstep, voffA);
    if (wr == 1) PG8_BAR;
    PG8_WAIT_V(4); PG8_BAR;
    PG8_STAGE(PG8_SB(1, 0), cB + kstep, voffB); PG8_STAGE(PG8_SA(1, 0), cA + kstep, voffA); PG8_STAGE(PG8_SB(1, 1), cB + hstep + kstep, voffB);
    PG8_WAIT_V(6); PG8_BAR;
    PG8_STAMP();
    for (;;) {
        const bool has_next = S.next(ui + 1, nxt);
        const char* nA = has_next ? (const char*)g.A + (size_t)nxt.pm * tstep : cA; const char* nB = has_next ? (const char*)g.Bt + (size_t)nxt.pn * tstep : cB;
        for (int t = 0; t < nt; t += 2) {
            const bool last = (t == nt - 2);
            const char* a1 = cA + (size_t)(t + 1) * kstep;
            const char* a2 = last ? nA : cA + (size_t)(t + 2) * kstep; const char* b2 = last ? nB : cB + (size_t)(t + 2) * kstep;
            const char* a3 = a2 + kstep; const char* b3 = b2 + kstep;
            if (last && has_next) S.a_ready(nxt);
            PG8_LDB(B0, 0, 0); PG8_SCHED; PG8_LDA(At, 0, 0); PG8_STAGE(PG8_SA(1, 1), a1 + hstep, voffA);
            PG8_WAIT_L(8); PG8_BAR; PG8_WAIT_L(0); PG8_MMA(0, 0, At, B0); PG8_BAR; PG8_SCHED;
            PG8_LDB(B1, 0, 1); PG8_STAGE(PG8_SB(0, 0), b2, voffB);
            PG8_BAR; PG8_WAIT_L(0); PG8_MMA(0, 1, At, B1); PG8_BAR;
            PG8_LDA(At, 0, 1); PG8_STAGE(PG8_SA(0, 0), a2, voffA);
            PG8_BAR; PG8_WAIT_L(0); PG8_MMA(1, 0, At, B0); PG8_BAR; PG8_SCHED;
            PG8_STAGE(PG8_SB(0, 1), b2 + hstep, voffB);
            PG8_WAIT_V(6); PG8_BAR; PG8_MMA(1, 1, At, B1); PG8_BAR;
            PG8_LDB(B0, 1, 0); PG8_SCHED; PG8_LDA(At, 1, 0); PG8_STAGE(PG8_SA(0, 1), a2 + hstep, voffA);
            PG8_WAIT_L(8); PG8_BAR; PG8_WAIT_L(0); PG8_MMA(0, 0, At, B0); PG8_BAR; PG8_SCHED;
            PG8_LDB(B1, 1, 1); PG8_STAGE(PG8_SB(1, 0), b3, voffB);
            PG8_BAR; PG8_WAIT_L(0); PG8_MMA(0, 1, At, B1); PG8_BAR;
            PG8_LDA(At, 1, 1); PG8_STAGE(PG8_SA(1, 0), a3, voffA);
            PG8_BAR; PG8_WAIT_L(0); PG8_MMA(1, 0, At, B0); PG8_BAR; PG8_SCHED;
            PG8_STAGE(PG8_SB(1, 1), b3 + hstep, voffB);
            PG8_WAIT_V(6); PG8_BAR; PG8_MMA(1, 1, At, B1); PG8_BAR;
        }
        PG8_STAMP();
        if constexpr (!Epi::AFTER_DRAIN) { E(acc, cur, wr, wc, fr, fq); S.done(cur); }
        PG8_STAMP();
        if (!has_next) break;
#pragma unroll
        for (int a = 0; a < 2; ++a)
#pragma unroll
            for (int b = 0; b < 2; ++b)
#pragma unroll
                for (int m = 0; m < 4; ++m)
#pragma unroll
                    for (int n = 0; n < 2; ++n) acc[a][b][m][n] = (f32x4){0.f, 0.f, 0.f, 0.f};
        cur = nxt; cA = nA; cB = nB; ++ui;
    }
    PG8_WAIT_V(0);
    if (wr == 0) PG8_BAR;
    PG8_BAR;
    if constexpr (Epi::AFTER_DRAIN) { E.fused(acc, cur, wr, wc, fr, fq, lds, wid, lane); S.done(cur); }
    PG8_STAMP();
    if (STAMP && wid == 0) { stamps[lane] = lane < nts ? (((unsigned long long)(unsigned)ts_hi << 32) | (unsigned)ts_lo) : 0ull;
        if (lane == 62) stamps[62] = rt_entry; if (lane == 63) stamps[63] = (unsigned long long)wall_clock64(); }
#undef PG8_STAMP
#undef PG8_SA
#undef PG8_SB
#undef PG8_STAGE
#undef PG8_LDA
#undef PG8_LDB
#undef PG8_MMA
#undef PG8_WAIT_V
#undef PG8_WAIT_L
#undef PG8_BAR
#undef PG8_SCHED
}
}

namespace cg = cooperative_groups;
#define LAS __attribute__((address_space(3)))
typedef unsigned short bf16_t;
typedef short bf16x8 __attribute__((ext_vector_type(8)));
typedef short s16x4 __attribute__((ext_vector_type(4)));
typedef float f32x4 __attribute__((ext_vector_type(4)));
typedef float f32x16 __attribute__((ext_vector_type(16)));
typedef unsigned u32x4 __attribute__((ext_vector_type(4)));
typedef unsigned u32x2 __attribute__((ext_vector_type(2)));

constexpr int DM = 2048, M_CTX = 4096, M_ALL = 12288, NIN = 9216;
constexpr float EPS = 1e-6f;
constexpr size_t SLOT = (size_t)M_ALL * 1024 * 2;
constexpr size_t WS_PROJ = 0;
constexpr size_t WS_WINT = 9 * SLOT;
constexpr size_t WS_WOUTT = 11 * SLOT;
constexpr size_t WS_PART = WS_WOUTT + (size_t)2048 * 2048 * 2;
constexpr size_t WS_GATE = WS_PART + (size_t)16 * 3 * 6144 * 4;
constexpr size_t WS_MOD = WS_GATE + 3 * 2048 * 4;
constexpr size_t WS_EVEC = WS_MOD + 3 * 6144 * 4;
constexpr size_t WS_ROPE = WS_EVEC + (size_t)192 * 8 * 2 * 128 * 4;
constexpr size_t WS_LB = WS_ROPE + 64 * 32 * 2 * 4;
constexpr size_t WS_LG = WS_LB + 2 * 1024 * 4;
constexpr size_t WS_BAR = WS_LG + 256;
constexpr size_t WS_PCNT = WS_BAR + 16384;
constexpr size_t WS_BAR2 = WS_PCNT + 48 * 256;
constexpr size_t WS_XCH = WS_BAR2 + 16384;
constexpr size_t WS_END = WS_XCH + (size_t)M_ALL * 8 * 4;
constexpr size_t WS_OMIX = 4 * SLOT;
constexpr size_t WS_XS = 0;
constexpr int LDS_BYTES = 163840;

struct Args { const float* in[17]; float* out; unsigned char* ws; };
__device__ __forceinline__ size_t pk2_off(int row, int col) { return ((size_t)((row >> 6) * 16 + (col >> 7)) * 64 + (row & 63)) * 128 + (col & 127); }
__device__ __forceinline__ size_t pk_off(int row, int col) { return ((size_t)((row >> 6) * 8 + (col >> 7)) * 64 + (row & 63)) * 128 + (col & 127); }
#ifndef REP_LAT
#define REP_LAT 1
#endif
#ifndef REP_P0
#define REP_P0 1
#endif
#ifndef REP_P1
#define REP_P1 1
#endif
#ifndef REP_P2
#define REP_P2 1
#endif
#ifndef REP_P4
#define REP_P4 1
#endif
#ifndef REP_P4B
#define REP_P4B 1
#endif
#ifndef REP_P5
#define REP_P5 1
#endif
#ifndef REP_P6
#define REP_P6 1
#endif

__device__ __forceinline__ unsigned cvtpk(float lo, float hi) { unsigned r; asm volatile("v_cvt_pk_bf16_f32 %0, %1, %2" : "=v"(r) : "v"(lo), "v"(hi)); return r; }
__device__ __forceinline__ float bflo(unsigned u) { return __builtin_bit_cast(float, u << 16); }
__device__ __forceinline__ float bfhi(unsigned u) { return __builtin_bit_cast(float, u & 0xffff0000u); }
__device__ __forceinline__ float bf2f(bf16_t b) { return __builtin_bit_cast(float, (unsigned)b << 16); }
__device__ __forceinline__ float wave_sum(float v) {
#pragma unroll
    for (int o = 1; o < 64; o <<= 1) v += __shfl_xor(v, o);
    return v;
}
#define LDS_WAIT() asm volatile("s_waitcnt lgkmcnt(0)" ::: "memory")
#define BAR_LDS() do { asm volatile("s_waitcnt lgkmcnt(0)" ::: "memory"); __builtin_amdgcn_s_barrier(); asm volatile("" ::: "memory"); } while (0)
#define MFMA32(a, b, c) __builtin_amdgcn_mfma_f32_32x32x16_bf16((a), (b), (c), 0, 0, 0)
#define PRIO_HI() __builtin_amdgcn_s_setprio(1)
#define PRIO_LO() __builtin_amdgcn_s_setprio(0)

#define RLX_AGENT __ATOMIC_RELAXED, __HIP_MEMORY_SCOPE_AGENT
#define XB_TMO      128
#define XB_XCNT(j)  (256  + 64 * (j))
#define XB_XSUB(j)  (1280 + 64 * (j))
#define XB_XGEN(j)  (2304 + 64 * (j))
#define XB_TOP      3328
#define XB_TOPGEN   3392
#define XCD_BAR_WORDS 3456
#define XB_SPIN_CAP (1u << 18)

__device__ __forceinline__ unsigned xb_ld(unsigned* p)              { return __hip_atomic_load(p, __ATOMIC_RELAXED, __HIP_MEMORY_SCOPE_AGENT); }
__device__ __forceinline__ unsigned xb_add(unsigned* p, unsigned v) { return __hip_atomic_fetch_add(p, v, __ATOMIC_RELAXED, __HIP_MEMORY_SCOPE_AGENT); }
__device__ __forceinline__ unsigned xb_xcc_id() { return (unsigned)__builtin_amdgcn_s_getreg((3 << 11) | 20) & 0xFu; }
#define XB_SPIN(cond, bar) do { unsigned _sp = 0; while (cond) { __builtin_amdgcn_s_sleep(1); \
    if ((++_sp & 255u) == 0u) { if (xb_ld(&(bar)[XB_TMO])) break; if (_sp > XB_SPIN_CAP) { atomicAdd(&(bar)[XB_TMO], 1u); break; } } } } while (0)

struct XcdBarrier {
    unsigned* bar; unsigned x; unsigned G;
    volatile LAS unsigned* st;
};

__device__ __forceinline__ XcdBarrier xcd_barrier_post(unsigned* bar, volatile LAS unsigned* st, unsigned members) {
    XcdBarrier b; b.bar = bar; b.x = xb_xcc_id(); b.st = st; b.G = members;
    if (threadIdx.x == 0) (void)xb_add(&bar[XB_XCNT(b.x)], 1u);
    return b;
}
__device__ __forceinline__ void xcd_barrier_complete(unsigned* bar, unsigned x, unsigned G, unsigned& nloc, unsigned& nx) {
    unsigned sum, cnt, mine, sp = 0u;
    for (;;) {
        sum = 0u; cnt = 0u; mine = 0u;
#pragma unroll
        for (unsigned j = 0; j < 16; ++j) { const unsigned c = xb_ld(&bar[XB_XCNT(j)]); sum += c; cnt += (c > 0u) ? 1u : 0u; mine = (j == x) ? c : mine; }
        if (sum == G) break;
        __builtin_amdgcn_s_sleep(1);
        if ((++sp & 255u) == 0u) { if (xb_ld(&bar[XB_TMO])) break; if (sp > XB_SPIN_CAP) { atomicAdd(&bar[XB_TMO], 1u); break; } }
    }
    nloc = mine > 0u ? mine : 1u; nx = cnt > 0u ? cnt : 1u;
}

__device__ __forceinline__ void xcd_barrier(const XcdBarrier& b) {
    asm volatile("s_waitcnt vmcnt(0)" ::: "memory");
    __syncthreads();
    if (threadIdx.x == 0) {
        unsigned* bar = b.bar;
        __builtin_amdgcn_s_waitcnt(0);
        unsigned nloc = b.st[0], nx = b.st[1];
        if (nloc == 0u) { xcd_barrier_complete(bar, b.x, b.G, nloc, nx); b.st[0] = nloc; b.st[1] = nx; }
        const unsigned old = xb_add(&bar[XB_XSUB(b.x)], 1u);
        const unsigned gen = old / nloc;
        if (old + 1u == (gen + 1u) * nloc) {
            __builtin_amdgcn_fence(__ATOMIC_RELEASE, "agent");
            asm volatile("s_waitcnt vmcnt(0)" ::: "memory");
            const unsigned og = xb_add(&bar[XB_TOP], 1u);
            const unsigned tg = og / nx;
            if (og + 1u == (tg + 1u) * nx) xb_add(&bar[XB_TOPGEN], 1u);
            else XB_SPIN(xb_ld(&bar[XB_TOPGEN]) == tg, bar);
            __builtin_amdgcn_fence(__ATOMIC_ACQUIRE, "agent");
            xb_add(&bar[XB_XGEN(b.x)], 1u);
            asm volatile("s_waitcnt vmcnt(0)" ::: "memory");
        } else {
            XB_SPIN(xb_ld(&bar[XB_XGEN(b.x)]) == gen, bar);
            __builtin_amdgcn_fence(__ATOMIC_ACQUIRE, "agent");
            asm volatile("s_waitcnt vmcnt(0)" ::: "memory");
        }
    }
    __syncthreads();
}

__device__ __forceinline__ void sub_barrier(unsigned* cnt, unsigned nblk, unsigned& gen) {
    asm volatile("s_waitcnt vmcnt(0)" ::: "memory");
    __syncthreads();
    if (threadIdx.x == 0) {
        __builtin_amdgcn_fence(__ATOMIC_RELEASE, "agent");
        asm volatile("s_waitcnt vmcnt(0)" ::: "memory");
        xb_add(cnt, 1u);
        const unsigned target = (gen + 1u) * nblk; unsigned sp = 0u;
        while (xb_ld(cnt) < target) { __builtin_amdgcn_s_sleep(1); if (++sp > (1u << 22)) break; }
        __builtin_amdgcn_fence(__ATOMIC_ACQUIRE, "agent");
        asm volatile("s_waitcnt vmcnt(0)" ::: "memory");
    }
    ++gen;
    __syncthreads();
}

__device__ __forceinline__ void p0_transpose_item(const float* W, int K, int N, bf16_t* WT, LAS float* scr, int item, int lane, int sc_lo, int sc_hi, float scale, int rope_cols) {
    const int nblk = N / 32, kb = item / nblk, nb = item % nblk, k0 = 64 * kb, n0 = 32 * nb;
    const float sc = (n0 >= sc_lo && n0 < sc_hi) ? scale : 1.0f;
    {
        f32x4 t[8];
        int csrc = n0 + 4 * (lane & 7);
        if (csrc < rope_cols) { const int pp = csrc & 127; csrc = (csrc & ~127) + 64 * (pp >> 6) + 4 * ((pp >> 3) & 7) + 32 * ((pp >> 2) & 1); }
#pragma unroll
        for (int i = 0; i < 8; ++i) t[i] = __builtin_nontemporal_load((const f32x4*)(W + (size_t)(k0 + (lane >> 3) + 8 * i) * N + csrc));
#pragma unroll
        for (int i = 0; i < 8; ++i) { LAS float* d = scr + ((lane >> 3) + 8 * i) * 33 + 4 * (lane & 7); d[0] = t[i].x * sc; d[1] = t[i].y * sc; d[2] = t[i].z * sc; d[3] = t[i].w * sc; }
    }
    LDS_WAIT();
    const int c = lane & 7;
#pragma unroll
    for (int j = 0; j < 4; ++j) { const int n = (lane >> 3) + 8 * j; const LAS float* s = scr + (8 * c) * 33 + n;
        u32x4 o; o.x = cvtpk(s[0 * 33], s[1 * 33]); o.y = cvtpk(s[2 * 33], s[3 * 33]); o.z = cvtpk(s[4 * 33], s[5 * 33]); o.w = cvtpk(s[6 * 33], s[7 * 33]);
        *(u32x4*)(WT + (size_t)(n0 + n) * K + k0 + 8 * c) = o; }
    LDS_WAIT();
}
__device__ __forceinline__ void p0_gemv_task(const Args& a, int task, LAS float* scr, int lane) {
    const int cgp = task % 24, ks = task / 24;
#pragma unroll
    for (int m = 0; m < 3; ++m)
#pragma unroll
        for (int hf = 0; hf < 2; ++hf) { const int k = 128 * ks + 64 * hf + lane; const float c = (m == 0) ? a.in[7][k] : a.in[6][(m - 1) * 2048 + k];
            scr[m * 128 + 64 * hf + lane] = c / (1.0f + __expf(-c)); }
    LDS_WAIT();
    const float* w = a.in[9] + (size_t)(128 * ks) * 6144 + 256 * cgp + 4 * lane;
    f32x4 a0 = {0.f, 0.f, 0.f, 0.f}, a1 = a0, a2 = a0;
#pragma unroll 16
    for (int kk = 0; kk < 128; ++kk) { const f32x4 wv = __builtin_nontemporal_load((const f32x4*)(w + (size_t)kk * 6144)); a0 += scr[kk] * wv; a1 += scr[128 + kk] * wv; a2 += scr[256 + kk] * wv; }
    float* part = (float*)(a.ws + WS_PART) + (size_t)(ks * 3) * 6144 + 256 * cgp + 4 * lane;
    *(f32x4*)(part) = a0; *(f32x4*)(part + 6144) = a1; *(f32x4*)(part + 2 * 6144) = a2;
    LDS_WAIT();
}
__device__ __forceinline__ void phase0(const Args& a, LAS unsigned char* lds) {
    const int tid = threadIdx.x, lane = tid & 63, wave = tid >> 6;
    LAS float* scr = (LAS float*)(lds + wave * 16384);
    const int gw = blockIdx.x * 8 + wave, NGW = gridDim.x * 8;
    constexpr int T_GEMV = 24 * 16, T_WIN = 32 * (NIN / 32), T_WOUT = 32 * (2048 / 32);
    for (int t = gw; t < T_GEMV + T_WIN + T_WOUT; t += NGW) {
        const int q30 = t / 30, ng = (t + 29) / 30 < T_GEMV ? (t + 29) / 30 : T_GEMV;
        if (t % 30 == 0 && q30 < T_GEMV) { p0_gemv_task(a, q30, scr, lane); continue; }
        const int it = t - ng;
        if (it < T_WIN) p0_transpose_item(a.in[11], 2048, NIN, (bf16_t*)(a.ws + WS_WINT), scr, it, lane, 1024, 2048, 0.08838834764831845f, 2048);
        else p0_transpose_item(a.in[15], 2048, 2048, (bf16_t*)(a.ws + WS_WOUTT), scr, it - T_WIN, lane, 0, 0, 1.0f, 0);
    }
    const int gt = blockIdx.x * 512 + tid;
    if (gt < 2048) { const int pos = gt >> 5, f = gt & 31; const float fr = powf(10000.0f, -(float)f / 32.0f); const float ang = (float)pos * fr;
        float* r = (float*)(a.ws + WS_ROPE); r[2 * gt] = cosf(ang); r[2 * gt + 1] = sinf(ang); }
    else if (gt < 4096) { const int i = gt - 2048, dir = i >> 10, col = i & 1023; const float x0 = a.in[13][dir * 2048 + col], x1 = a.in[13][dir * 2048 + 1024 + col];
        ((float*)(a.ws + WS_LB))[i] = 1.0f / (1.0f + expf(x1 - x0)); }
    else if (gt < 4096 + 16) { const int i = gt - 4096; ((float*)(a.ws + WS_LG))[i] = log1pf(-expf(a.in[12][i])); }
}

__device__ __forceinline__ void phase0b(const Args& a) {
    const float* part = (const float*)(a.ws + WS_PART);
    for (int idx = blockIdx.x * 512 + threadIdx.x; idx < 3 * 6144; idx += gridDim.x * 512) { const int m = idx / 6144, c = idx % 6144; float sacc = a.in[10][c];
#pragma unroll
        for (int ks = 0; ks < 16; ++ks) sacc += part[(size_t)(ks * 3 + m) * 6144 + c];
        ((float*)(a.ws + WS_MOD))[idx] = sacc;
        if (c >= 4096) ((float*)(a.ws + WS_GATE))[m * 2048 + c - 4096] = sacc; }
}

__device__ __forceinline__ void phase1(const Args& a, LAS unsigned char* lds) {
    const int tid = threadIdx.x, lane = tid & 63, wave = tid >> 6;
    LAS float* AT = (LAS float*)lds;
    LAS float* ST = (LAS float*)(lds + 24576);
    const float* mod = (const float*)(a.ws + WS_MOD);
    for (int idx = tid; idx < 3 * 2048; idx += 512) { const int m = idx >> 11, c = idx & 2047;
        ST[idx] = mod[m * 6144 + c]; AT[idx] = a.in[8][c] * (1.0f + mod[m * 6144 + 2048 + c]); }
    __syncthreads();
    bf16_t* H = (bf16_t*)a.out;
    const int gw = blockIdx.x * 8 + wave, NGW = gridDim.x * 8;
    f32x4 vn[8];
    { const int row = gw; const float* xr = row < M_CTX ? a.in[0] + (size_t)row * DM : a.in[1] + (size_t)(row - M_CTX) * DM;
#pragma unroll
      for (int j = 0; j < 8; ++j) vn[j] = __builtin_nontemporal_load((const f32x4*)(xr + 4 * lane + 256 * j)); }
#pragma unroll 1
    for (int row = gw; row < M_ALL; row += NGW) {
        const int m = row < M_CTX ? 0 : 1 + ((row - M_CTX) >> 12);
        f32x4 v[8]; float ss = 0.f;
#pragma unroll
        for (int j = 0; j < 8; ++j) { v[j] = vn[j]; ss += (v[j].x * v[j].x + v[j].y * v[j].y) + (v[j].z * v[j].z + v[j].w * v[j].w); }
        if (row + NGW < M_ALL) { const int rn = row + NGW; const float* xr = rn < M_CTX ? a.in[0] + (size_t)rn * DM : a.in[1] + (size_t)(rn - M_CTX) * DM;
#pragma unroll
            for (int j = 0; j < 8; ++j) vn[j] = __builtin_nontemporal_load((const f32x4*)(xr + 4 * lane + 256 * j)); }
        const float rstd = 1.0f / sqrtf(wave_sum(ss) * (1.0f / DM) + EPS);
#pragma unroll
        for (int j = 0; j < 8; ++j) { const f32x4 av = *(const LAS f32x4*)(AT + m * 2048 + 4 * lane + 256 * j), sv = *(const LAS f32x4*)(ST + m * 2048 + 4 * lane + 256 * j);
            const f32x4 hv = v[j] * rstd * av + sv; u32x2 o; o.x = cvtpk(hv.x, hv.y); o.y = cvtpk(hv.z, hv.w);
            *(u32x2*)(H + (size_t)row * DM + 4 * lane + 256 * j) = o; }
    }
}

__device__ __forceinline__ bf16_t* slotp(const Args& a, int s) { return (bf16_t*)(a.ws + WS_PROJ + (size_t)s * SLOT); }
__device__ __forceinline__ bf16_t* obase(const Args& a, int dir, int lat) {
    bf16_t* o = (bf16_t*)a.out;
    return lat ? o + (size_t)2 * M_CTX * DM + (size_t)dir * (M_ALL - M_CTX) * DM - (size_t)M_CTX * DM : o + (size_t)dir * M_CTX * DM;
}
__device__ __forceinline__ float* xs_row(const Args& a, int row) {
    return row < M_CTX ? (float*)(a.ws + WS_PROJ + (size_t)(row >> 10) * SLOT + (size_t)(row & 1023) * 8192) : (float*)(a.ws + WS_XS) + (size_t)row * DM;
}
__device__ __forceinline__ void phase3(const Args& a, LAS unsigned char* lds) {
    const int tid = threadIdx.x;
    {
        const int sub = tid >> 8, dir = (tid >> 7) & 1, d = tid & 127;
        const float* LB = (const float*)(a.ws + WS_LB); float* EV = (float*)(a.ws + WS_EVEC);
        u32x4 pre[12];
#define P3_LOAD(p_) do { const int cg_ = (p_) >> 2, hp_ = (p_) & 3; \
            _Pragma("unroll") for (int u_ = 0; u_ < 12; ++u_) { const int n_ = tid + 512 * u_, tile_ = n_ >> 10, row_ = (n_ >> 4) & 63, ch_ = n_ & 15; const int sb_ = tile_ / 3, kind_ = tile_ % 3; \
                pre[u_] = *(const u32x4*)(slotp(a, 4 + kind_) + pk_off(cg_ * 64 + row_, (2 * hp_ + sb_) * 128 + ch_ * 8)); } } while (0)
        int p = blockIdx.x;
        if (p < 768) P3_LOAD(p);
        for (; p < 768; p += gridDim.x) {
            const int h = 2 * (p & 3) + sub, cgi = p >> 2, col = h * 128 + d;
            BAR_LDS();
#pragma unroll
            for (int u = 0; u < 12; ++u) *(LAS u32x4*)(lds + 16 * (tid + 512 * u)) = pre[u];
            BAR_LDS();
            if (p + (int)gridDim.x < 768) P3_LOAD(p + (int)gridDim.x);
            if (tid < 256) {
                const int sub2 = tid >> 7, dir2 = (tid >> 6) & 1, dp = tid & 63, h2 = 2 * (p & 3) + sub2, col2 = h2 * 128 + 2 * dp;
                const LAS unsigned* qt = (const LAS unsigned*)(lds + (sub2 * 3 + 0) * 16384) + dp;
                LAS unsigned* zt = (LAS unsigned*)(lds + (sub2 * 3 + 1 + dir2) * 16384) + dp;
                unsigned* qo = (unsigned*)(slotp(a, 9 + dir2) + pk_off(cgi * 64, col2));
                const float lb0 = LB[dir2 * 1024 + col2], lb1 = LB[dir2 * 1024 + col2 + 1]; float b0 = 0.f, b1 = 0.f;
#pragma unroll 1
                for (int i0 = 0; i0 < 64; i0 += 8) {
                    unsigned zz[8], qq[8]; float f0[8], f1[8], c0[8], c1[8];
#pragma unroll
                    for (int u = 0; u < 8; ++u) { const int r = dir2 ? 63 - (i0 + u) : (i0 + u); zz[u] = zt[r * 64]; qq[u] = qt[r * 64]; }
#pragma unroll
                    for (int u = 0; u < 8; ++u) {
                        const float s0 = __builtin_amdgcn_rcpf(1.0f + __builtin_amdgcn_exp2f(-1.4426950408889634f * bflo(zz[u]))), s1 = __builtin_amdgcn_rcpf(1.0f + __builtin_amdgcn_exp2f(-1.4426950408889634f * bfhi(zz[u])));
                        f0[u] = lb0 + (1.0f - lb0) * s0; f1[u] = lb1 + (1.0f - lb1) * s1; c0[u] = __builtin_amdgcn_logf(f0[u]); c1[u] = __builtin_amdgcn_logf(f1[u]); }
#pragma unroll
                    for (int u = 0; u < 8; ++u) { b0 += c0[u]; c0[u] = b0; b1 += c1[u]; c1[u] = b1; }
#pragma unroll
                    for (int u = 0; u < 8; ++u) { const int r = dir2 ? 63 - (i0 + u) : (i0 + u);
                        const float e0 = __builtin_amdgcn_exp2f(c0[u]), i0e = __builtin_amdgcn_exp2f(-c0[u]), e1 = __builtin_amdgcn_exp2f(c1[u]), i1e = __builtin_amdgcn_exp2f(-c1[u]);
                        qo[(size_t)r * 64] = cvtpk(bflo(qq[u]) * e0, bfhi(qq[u]) * e1); zt[r * 64] = cvtpk((1.0f - f0[u]) * i0e, (1.0f - f1[u]) * i1e); }
                }
                float* evp = EV + ((size_t)(cgi * 8 + h2) * 2 + dir2) * 128 + 2 * dp;
                evp[0] = __builtin_amdgcn_exp2f(b0); evp[1] = __builtin_amdgcn_exp2f(b1);
            }
            BAR_LDS();
#pragma unroll
            for (int u = 0; u < 8; ++u) { const int n = tid + 512 * u, t4 = n >> 10, row = (n >> 4) & 63, ch = n & 15; const int sb = t4 >> 1, dr = t4 & 1;
                const u32x4 v = *(const LAS u32x4*)(lds + (sb * 3 + 1 + dr) * 16384 + row * 256 + ch * 16);
                *(u32x4*)(slotp(a, 5 + dr) + pk_off(cgi * 64 + row, (2 * (p & 3) + sb) * 128 + ch * 8)) = v; }
        }
#undef P3_LOAD
        BAR_LDS();
    }
}

__device__ __forceinline__ unsigned off_b(unsigned row, unsigned ch) { return 256u * row + 16u * (ch ^ (((row & 3) << 2) | ((row >> 2) & 3))); }
__device__ __forceinline__ unsigned tr_addr(unsigned lane, unsigned c, unsigned ks, unsigned t) {
    const unsigned h = lane >> 5, blk = (lane >> 4) & 1, q = (lane & 15) >> 2, p = lane & 3;
    return off_b(16 * ks + 8 * h + 4 * t + q, 4 * c + 2 * blk + (p >> 1)) + 8 * (p & 1);
}
__device__ __forceinline__ unsigned pt_off(unsigned i, unsigned ch) { return 128u * i + 16u * (ch ^ ((i >> 1) & 7)); }
template <bool WAIT = true> __device__ __forceinline__ void tr_frag4(unsigned base, unsigned lane, unsigned c, bf16x8 (&f)[4]) {
    s16x4 r0, r1, r2, r3, r4, r5, r6, r7;
    const unsigned a0 = base + tr_addr(lane, c, 0, 0), a1 = base + tr_addr(lane, c, 0, 1);
    if (WAIT) asm volatile("ds_read_b64_tr_b16 %0, %8\n\tds_read_b64_tr_b16 %1, %9\n\tds_read_b64_tr_b16 %2, %8 offset:4096\n\tds_read_b64_tr_b16 %3, %9 offset:4096\n\t"
                 "ds_read_b64_tr_b16 %4, %8 offset:8192\n\tds_read_b64_tr_b16 %5, %9 offset:8192\n\tds_read_b64_tr_b16 %6, %8 offset:12288\n\tds_read_b64_tr_b16 %7, %9 offset:12288\n\ts_waitcnt lgkmcnt(0)"
                 : "=&v"(r0), "=&v"(r1), "=&v"(r2), "=&v"(r3), "=&v"(r4), "=&v"(r5), "=&v"(r6), "=&v"(r7)
                 : "v"(a0), "v"(a1) : "memory");
    else asm volatile("ds_read_b64_tr_b16 %0, %8\n\tds_read_b64_tr_b16 %1, %9\n\tds_read_b64_tr_b16 %2, %8 offset:4096\n\tds_read_b64_tr_b16 %3, %9 offset:4096\n\t"
                 "ds_read_b64_tr_b16 %4, %8 offset:8192\n\tds_read_b64_tr_b16 %5, %9 offset:8192\n\tds_read_b64_tr_b16 %6, %8 offset:12288\n\tds_read_b64_tr_b16 %7, %9 offset:12288"
                 : "=&v"(r0), "=&v"(r1), "=&v"(r2), "=&v"(r3), "=&v"(r4), "=&v"(r5), "=&v"(r6), "=&v"(r7)
                 : "v"(a0), "v"(a1) : "memory");
    f[0] = __builtin_shufflevector(r0, r1, 0, 1, 2, 3, 4, 5, 6, 7); f[1] = __builtin_shufflevector(r2, r3, 0, 1, 2, 3, 4, 5, 6, 7);
    f[2] = __builtin_shufflevector(r4, r5, 0, 1, 2, 3, 4, 5, 6, 7); f[3] = __builtin_shufflevector(r6, r7, 0, 1, 2, 3, 4, 5, 6, 7);
}
template <bool WAIT = true> __device__ __forceinline__ void tr_frag8(unsigned base, unsigned lane, unsigned c, bf16x8 (&f)[4], bf16x8 (&g)[4]) {
    s16x4 r0, r1, r2, r3, r4, r5, r6, r7, q0, q1, q2, q3, q4, q5, q6, q7;
    const unsigned a0 = base + tr_addr(lane, c, 0, 0), a1 = base + tr_addr(lane, c, 0, 1), b0 = base + tr_addr(lane, c + 1, 0, 0), b1 = base + tr_addr(lane, c + 1, 0, 1);
    if (WAIT) asm volatile("ds_read_b64_tr_b16 %0, %16\n\tds_read_b64_tr_b16 %1, %17\n\tds_read_b64_tr_b16 %2, %16 offset:4096\n\tds_read_b64_tr_b16 %3, %17 offset:4096\n\t"
                 "ds_read_b64_tr_b16 %4, %16 offset:8192\n\tds_read_b64_tr_b16 %5, %17 offset:8192\n\tds_read_b64_tr_b16 %6, %16 offset:12288\n\tds_read_b64_tr_b16 %7, %17 offset:12288\n\t"
                 "ds_read_b64_tr_b16 %8, %18\n\tds_read_b64_tr_b16 %9, %19\n\tds_read_b64_tr_b16 %10, %18 offset:4096\n\tds_read_b64_tr_b16 %11, %19 offset:4096\n\t"
                 "ds_read_b64_tr_b16 %12, %18 offset:8192\n\tds_read_b64_tr_b16 %13, %19 offset:8192\n\tds_read_b64_tr_b16 %14, %18 offset:12288\n\tds_read_b64_tr_b16 %15, %19 offset:12288\n\ts_waitcnt lgkmcnt(0)"
                 : "=&v"(r0), "=&v"(r1), "=&v"(r2), "=&v"(r3), "=&v"(r4), "=&v"(r5), "=&v"(r6), "=&v"(r7), "=&v"(q0), "=&v"(q1), "=&v"(q2), "=&v"(q3), "=&v"(q4), "=&v"(q5), "=&v"(q6), "=&v"(q7)
                 : "v"(a0), "v"(a1), "v"(b0), "v"(b1) : "memory");
    else asm volatile("ds_read_b64_tr_b16 %0, %16\n\tds_read_b64_tr_b16 %1, %17\n\tds_read_b64_tr_b16 %2, %16 offset:4096\n\tds_read_b64_tr_b16 %3, %17 offset:4096\n\t"
                 "ds_read_b64_tr_b16 %4, %16 offset:8192\n\tds_read_b64_tr_b16 %5, %17 offset:8192\n\tds_read_b64_tr_b16 %6, %16 offset:12288\n\tds_read_b64_tr_b16 %7, %17 offset:12288\n\t"
                 "ds_read_b64_tr_b16 %8, %18\n\tds_read_b64_tr_b16 %9, %19\n\tds_read_b64_tr_b16 %10, %18 offset:4096\n\tds_read_b64_tr_b16 %11, %19 offset:4096\n\t"
                 "ds_read_b64_tr_b16 %12, %18 offset:8192\n\tds_read_b64_tr_b16 %13, %19 offset:8192\n\tds_read_b64_tr_b16 %14, %18 offset:12288\n\tds_read_b64_tr_b16 %15, %19 offset:12288"
                 : "=&v"(r0), "=&v"(r1), "=&v"(r2), "=&v"(r3), "=&v"(r4), "=&v"(r5), "=&v"(r6), "=&v"(r7), "=&v"(q0), "=&v"(q1), "=&v"(q2), "=&v"(q3), "=&v"(q4), "=&v"(q5), "=&v"(q6), "=&v"(q7)
                 : "v"(a0), "v"(a1), "v"(b0), "v"(b1) : "memory");
    f[0] = __builtin_shufflevector(r0, r1, 0, 1, 2, 3, 4, 5, 6, 7); f[1] = __builtin_shufflevector(r2, r3, 0, 1, 2, 3, 4, 5, 6, 7);
    f[2] = __builtin_shufflevector(r4, r5, 0, 1, 2, 3, 4, 5, 6, 7); f[3] = __builtin_shufflevector(r6, r7, 0, 1, 2, 3, 4, 5, 6, 7);
    g[0] = __builtin_shufflevector(q0, q1, 0, 1, 2, 3, 4, 5, 6, 7); g[1] = __builtin_shufflevector(q2, q3, 0, 1, 2, 3, 4, 5, 6, 7);
    g[2] = __builtin_shufflevector(q4, q5, 0, 1, 2, 3, 4, 5, 6, 7); g[3] = __builtin_shufflevector(q6, q7, 0, 1, 2, 3, 4, 5, 6, 7);
}
template <bool WAIT> __device__ __forceinline__ void lds_rd8(const unsigned (&ad)[8], bf16x8 (&f)[8]) {
    if (WAIT) asm volatile("ds_read_b128 %0, %8\n\tds_read_b128 %1, %9\n\tds_read_b128 %2, %10\n\tds_read_b128 %3, %11\n\tds_read_b128 %4, %12\n\tds_read_b128 %5, %13\n\tds_read_b128 %6, %14\n\tds_read_b128 %7, %15\n\ts_waitcnt lgkmcnt(0)"
                 : "=&v"(f[0]), "=&v"(f[1]), "=&v"(f[2]), "=&v"(f[3]), "=&v"(f[4]), "=&v"(f[5]), "=&v"(f[6]), "=&v"(f[7])
                 : "v"(ad[0]), "v"(ad[1]), "v"(ad[2]), "v"(ad[3]), "v"(ad[4]), "v"(ad[5]), "v"(ad[6]), "v"(ad[7]) : "memory");
    else asm volatile("ds_read_b128 %0, %8\n\tds_read_b128 %1, %9\n\tds_read_b128 %2, %10\n\tds_read_b128 %3, %11\n\tds_read_b128 %4, %12\n\tds_read_b128 %5, %13\n\tds_read_b128 %6, %14\n\tds_read_b128 %7, %15"
                 : "=&v"(f[0]), "=&v"(f[1]), "=&v"(f[2]), "=&v"(f[3]), "=&v"(f[4]), "=&v"(f[5]), "=&v"(f[6]), "=&v"(f[7])
                 : "v"(ad[0]), "v"(ad[1]), "v"(ad[2]), "v"(ad[3]), "v"(ad[4]), "v"(ad[5]), "v"(ad[6]), "v"(ad[7]) : "memory");
}
template <bool WAIT> __device__ __forceinline__ void lds_rd4(const unsigned (&ad)[4], bf16x8 (&f)[4]) {
    if (WAIT) asm volatile("ds_read_b128 %0, %4\n\tds_read_b128 %1, %5\n\tds_read_b128 %2, %6\n\tds_read_b128 %3, %7\n\ts_waitcnt lgkmcnt(0)"
                 : "=&v"(f[0]), "=&v"(f[1]), "=&v"(f[2]), "=&v"(f[3]) : "v"(ad[0]), "v"(ad[1]), "v"(ad[2]), "v"(ad[3]) : "memory");
    else asm volatile("ds_read_b128 %0, %4\n\tds_read_b128 %1, %5\n\tds_read_b128 %2, %6\n\tds_read_b128 %3, %7"
                 : "=&v"(f[0]), "=&v"(f[1]), "=&v"(f[2]), "=&v"(f[3]) : "v"(ad[0]), "v"(ad[1]), "v"(ad[2]), "v"(ad[3]) : "memory");
}
#define LGKM_WAIT_SCHED() do { asm volatile("s_waitcnt lgkmcnt(0)" ::: "memory"); __builtin_amdgcn_sched_barrier(0); } while (0)
__device__ __forceinline__ u32x4 scale_bf8(u32x4 x, float f) {
    u32x4 o;
#pragma unroll
    for (int e = 0; e < 4; ++e) o[e] = cvtpk(bflo(x[e]) * f, bfhi(x[e]) * f);
    return o;
}

constexpr unsigned L_T = 49152, L_QT = 0, L_KT = 16384, L_VT = 32768, L_SI = 98304, L_PT = 131072, L_PTSZ = 8192, L_EV = 147456, L_EVSZ = 512, L_DUMMY = 149504;

__device__ __forceinline__ void chain_item(const Args& a, LAS unsigned char* lds, int grp, int b, int h, int type, int dir) {
    const int tid = threadIdx.x, lane = tid & 63, w = __builtin_amdgcn_readfirstlane(tid >> 6), r = lane & 31, hh = lane >> 5;
    const unsigned lbase = (unsigned)(size_t)lds;
    const int nch = grp ? 64 : 4, rowbase = grp ? M_CTX + b * 4096 : b * 256;
    const bf16_t* qs = type ? slotp(a, 9 + dir) : slotp(a, 0);
    const bf16_t* ks_ = type ? slotp(a, 5 + dir) : slotp(a, 1);
    const bf16_t* vs = type ? slotp(a, 7) : slotp(a, 2);
    const float* EVg = (const float*)(a.ws + WS_EVEC);
    bf16_t* odir = obase(a, dir, grp);
    const float lg = type ? 0.f : ((const float*)(a.ws + WS_LG))[dir * 8 + h];
    const float sdec = __expf(lg * 64.0f);
    const int lrow0 = tid >> 4, lch = tid & 15;
    const size_t gcol = (size_t)h * 128 + lch * 8;
    const int vt = w & 3, it = w >> 2, dh = w >> 2;
    float pfac = 1.f, kfac0 = 1.f, kfac1 = 1.f, qfac0 = 1.f, qfac1 = 1.f;
    if (!type) { pfac = __expf(-lg * 64.0f);
        kfac0 = __expf(lg * (float)(dir ? lrow0 : 63 - lrow0)); kfac1 = __expf(lg * (float)(dir ? lrow0 + 32 : 31 - lrow0));
        qfac0 = __expf(lg * (float)(dir ? 64 - lrow0 : lrow0 + 1)); qfac1 = __expf(lg * (float)(dir ? 32 - lrow0 : lrow0 + 33)); }
    f32x16 S0, S1;
    if (grp) { const float* s0 = a.in[2 + type * 2 + dir] + (size_t)(b * 8 + h) * 16384;
#pragma unroll
        for (int t = 0; t < 16; ++t) { const int dd = (t & 3) + 8 * (t >> 2) + 4 * hh;
            S0[t] = s0[(size_t)(64 * dh + dd) * 128 + 32 * vt + r]; S1[t] = s0[(size_t)(64 * dh + 32 + dd) * 128 + 32 * vt + r]; } }
    else {
#pragma unroll
        for (int t = 0; t < 16; ++t) { S0[t] = 0.f; S1[t] = 0.f; } }
    u32x4 pq[2], pk[2]; float pe = 0.f;
#define CH_IDX(n) (dir ? nch - 1 - (n) : (n))
#define CH_LOAD(n) do { const int c__ = CH_IDX(n); const size_t rb_ = pk_off(rowbase + 64 * c__, h * 128) + (size_t)lch * 8; \
        _Pragma("unroll") for (int u_ = 0; u_ < 2; ++u_) { const size_t o_ = rb_ + (size_t)(lrow0 + 32 * u_) * 128; \
            pq[u_] = *(const u32x4*)(qs + o_); pk[u_] = *(const u32x4*)(ks_ + o_); } \
        if (type && tid < 128) pe = EVg[((size_t)(((rowbase >> 6) + c__) * 8 + h) * 2 + dir) * 128 + tid]; } while (0)
#define CH_STORE(TB, EB) do { \
        _Pragma("unroll") for (int u_ = 0; u_ < 2; ++u_) { const int row_ = lrow0 + 32 * u_; const unsigned o_ = (TB) + off_b(row_, lch); \
            u32x4 kk_ = pk[u_], qq_ = pq[u_]; if (!type) { kk_ = scale_bf8(kk_, u_ ? kfac1 : kfac0); qq_ = scale_bf8(qq_, u_ ? qfac1 : qfac0); } \
            *(LAS u32x4*)(lds + L_QT + o_) = qq_; *(LAS u32x4*)(lds + L_KT + o_) = kk_; } \
        if (type && tid < 128) *(LAS float*)(lds + L_EV + (EB) + 4 * tid) = pe; } while (0)
#define SI_STORE() do { \
        _Pragma("unroll") for (int g_ = 0; g_ < 4; ++g_) { \
            u32x2 x0_, x1_; x0_.x = cvtpk(S0[4 * g_], S0[4 * g_ + 1]); x0_.y = cvtpk(S0[4 * g_ + 2], S0[4 * g_ + 3]); x1_.x = cvtpk(S1[4 * g_], S1[4 * g_ + 1]); x1_.y = cvtpk(S1[4 * g_ + 2], S1[4 * g_ + 3]); \
            *(LAS u32x2*)(lds + L_SI + off_b(32 * vt + r, 4 * (2 * dh) + g_) + 8 * hh) = x0_; *(LAS u32x2*)(lds + L_SI + off_b(32 * vt + r, 4 * (2 * dh + 1) + g_) + 8 * hh) = x1_; } } while (0)
#define CH_VDMA(n, TB) do { const int c__ = CH_IDX(n); const bf16_t* vb_ = vs + pk_off(rowbase + 64 * c__, h * 128); \
        _Pragma("unroll") for (int u_ = 0; u_ < 2; ++u_) { const int p_ = w + 8 * u_, row_ = 4 * p_ + (lane >> 4), cst_ = lane & 15; \
            const int ch_ = cst_ ^ (((row_ & 3) << 2) | ((row_ >> 2) & 3)); \
            const bf16_t* src_ = vb_ + row_ * 128 + ch_ * 8; \
            const unsigned dst_ = (unsigned)__builtin_amdgcn_readfirstlane((int)(lbase + L_VT + (TB) + 1024u * (unsigned)p_)); \
            asm volatile("s_mov_b32 m0, %1\n\ts_nop 0\n\tglobal_load_lds_dwordx4 %0, off" :: "v"(src_), "s"(dst_) : "memory", "m0"); } } while (0)
#define CH_SCORES(LB, TB, PB) do { if (w < 4) { \
            const int jt_ = w >> 1, it2_ = w & 1; \
            f32x16 acc_; \
            _Pragma("unroll") for (int t_ = 0; t_ < 16; ++t_) acc_[t_] = 0.f; \
            { const unsigned oa_ = off_b(32 * jt_ + r, hh), ob_ = off_b(32 * it2_ + r, hh); \
              _Pragma("unroll") for (int hf_ = 0; hf_ < 2; ++hf_) { bf16x8 fx_[8]; unsigned ax_[8]; \
                _Pragma("unroll") for (int s_ = 0; s_ < 4; ++s_) { ax_[s_] = (LB) + L_KT + (TB) + (oa_ ^ (32u * (4 * hf_ + s_))); ax_[4 + s_] = (LB) + L_QT + (TB) + (ob_ ^ (32u * (4 * hf_ + s_))); } \
                lds_rd8<true>(ax_, fx_); \
                __builtin_amdgcn_sched_barrier(0); \
                _Pragma("unroll") for (int s_ = 0; s_ < 4; ++s_) acc_ = MFMA32(fx_[s_], fx_[4 + s_], acc_); \
                __builtin_amdgcn_sched_barrier(0); } } \
            const int i_ = 32 * it2_ + r; \
            _Pragma("unroll") for (int g_ = 0; g_ < 4; ++g_) { float x_[4]; \
                _Pragma("unroll") for (int e_ = 0; e_ < 4; ++e_) { const int j_ = 32 * jt_ + 8 * g_ + 4 * hh + e_; const bool keep_ = dir ? (j_ >= i_) : (i_ >= j_); x_[e_] = keep_ ? acc_[4 * g_ + e_] * pfac : 0.f; } \
                u32x2 o_; o_.x = cvtpk(x_[0], x_[1]); o_.y = cvtpk(x_[2], x_[3]); \
                *(LAS u32x2*)(lds + L_PT + (PB) + pt_off(i_, 4 * jt_ + g_) + 8 * hh) = o_; } } } while (0)

    BAR_LDS();
    CH_VDMA(0, 0u); CH_VDMA(1, L_T);
    CH_LOAD(0);
    CH_STORE(0u, 0u); SI_STORE();
    CH_LOAD(1);
    BAR_LDS();
    CH_SCORES(lbase, 0u, 0u);
    CH_STORE(L_T, L_EVSZ);
    if (2 < nch) CH_LOAD(2);
    BAR_LDS();
#pragma unroll 1
    for (int step = 0; step < nch; ++step) {
        unsigned zv; asm volatile("v_mov_b32 %0, 0" : "=v"(zv));
        const unsigned lb2 = lbase + zv;
        const unsigned par = (unsigned)(step & 1), tcur = par * L_T, tnxt = L_T - tcur, pcur = par * L_PTSZ, pnxt = L_PTSZ - pcur, ecur = par * L_EVSZ;
        const int row0 = rowbase + 64 * CH_IDX(step);
#ifdef PROBE_SLEEP
        __builtin_amdgcn_s_sleep(PROBE_SLEEP);
#endif
        if (step + 1 < nch) CH_SCORES(lb2, tnxt, pnxt);
        {
            bf16x8 vf_[4], kf_[4], kg_[4];
            const unsigned os0 = off_b(32 * vt + r, hh), oq0 = off_b(32 * it + r, hh), op0 = pt_off(32 * it + r, hh);
            __builtin_amdgcn_sched_barrier(0);
            tr_frag4<false>(lb2 + L_VT + tcur, lane, vt, vf_);
            tr_frag8<true>(lb2 + L_KT + tcur, lane, 2 * dh, kf_, kg_);
            __builtin_amdgcn_sched_barrier(0);
            if (!type) {
#pragma unroll
                for (int t = 0; t < 16; ++t) { S0[t] *= sdec; S1[t] *= sdec; } }
#pragma unroll
            for (int s2 = 0; s2 < 4; ++s2) { S0 = MFMA32(kf_[s2], vf_[s2], S0); S1 = MFMA32(kg_[s2], vf_[s2], S1); }
            __builtin_amdgcn_sched_barrier(0);
            f32x16 o1_;
#pragma unroll
            for (int t = 0; t < 16; ++t) o1_[t] = 0.f;
            { bf16x8 pb_[4], sq_[8];
              unsigned ap_[4], asq_[8];
#pragma unroll
              for (int s2 = 0; s2 < 4; ++s2) { ap_[s2] = lb2 + L_PT + pcur + (op0 ^ (32u * s2)); asq_[s2] = lb2 + L_SI + (os0 ^ (32u * s2)); asq_[4 + s2] = lb2 + L_QT + tcur + (oq0 ^ (32u * s2)); }
              lds_rd4<false>(ap_, pb_); lds_rd8<true>(asq_, sq_);
              __builtin_amdgcn_sched_barrier(0);
  #pragma unroll
              for (int s2 = 0; s2 < 4; ++s2) { o1_ = MFMA32(pb_[s2], vf_[s2], o1_); o1_ = MFMA32(sq_[4 + s2], sq_[s2], o1_); } }
            __builtin_amdgcn_sched_barrier(0);
            { bf16x8 sq2_[8]; unsigned asq_[8];
#pragma unroll
              for (int s2 = 0; s2 < 4; ++s2) { asq_[s2] = lb2 + L_SI + (os0 ^ (32u * (s2 + 4))); asq_[4 + s2] = lb2 + L_QT + tcur + (oq0 ^ (32u * (s2 + 4))); }
              lds_rd8<true>(asq_, sq2_);
              __builtin_amdgcn_sched_barrier(0);
  #pragma unroll
              for (int s2 = 0; s2 < 4; ++s2) o1_ = MFMA32(sq2_[4 + s2], sq2_[s2], o1_); }
            __builtin_amdgcn_sched_barrier(0);
            if (type) {
#pragma unroll
                for (int g = 0; g < 4; ++g) { const f32x4 e0_ = *(const LAS f32x4*)(lds + L_EV + ecur + 4 * (64 * dh + 8 * g + 4 * hh)), e1_ = *(const LAS f32x4*)(lds + L_EV + ecur + 4 * (64 * dh + 32 + 8 * g + 4 * hh));
#pragma unroll
                    for (int e = 0; e < 4; ++e) { S0[4 * g + e] *= e0_[e]; S1[4 * g + e] *= e1_[e]; } } }
            bf16_t* op_ = odir + pk2_off(row0 + 32 * it + 4 * hh, type * 1024 + h * 128 + 32 * vt + r);
#pragma unroll
            for (int t = 0; t < 16; ++t) op_[((t & 3) + 8 * (t >> 2)) * 128] = (bf16_t)(cvtpk(o1_[t], 0.f) & 0xffffu);
        }
        BAR_LDS();
        SI_STORE();
        if (step + 2 < nch) CH_STORE(tcur, ecur);
        if (step + 2 < nch) CH_VDMA(step + 2, tcur);
        if (step + 3 < nch) CH_LOAD(step + 3);
        else if (step + 1 < nch) asm volatile("s_waitcnt vmcnt(0)" ::: "memory");
        BAR_LDS();
    }
    if (!grp) {
        float* so = a.out + (size_t)M_ALL * DM + (size_t)(type * 2 + dir) * (16 * 8 * 16384) + (size_t)(b * 8 + h) * 16384;
#pragma unroll
        for (int t = 0; t < 16; ++t) { const int dd = (t & 3) + 8 * (t >> 2) + 4 * hh;
            so[(size_t)(64 * dh + dd) * 128 + 32 * vt + r] = S0[t]; so[(size_t)(64 * dh + 32 + dd) * 128 + 32 * vt + r] = S1[t]; }
    }
#undef CH_IDX
#undef CH_VDMA
#undef CH_LOAD
#undef CH_STORE
#undef SI_STORE
#undef CH_SCORES
}
__device__ __forceinline__ void p4b_finish(const Args& a, bf16_t* om, int idx, u32x4 xf, u32x4 xb, u32x4 gg) {
    const int l16 = idx & 15, seg = (idx >> 4) & 15, row = idx >> 8, type = seg >> 3;
    const size_t off = (size_t)row * DM + seg * 128 + l16 * 8;
    float o[8]; float ss = 0.f;
#pragma unroll
    for (int e = 0; e < 4; ++e) { o[2 * e] = bflo(xf[e]) + bflo(xb[e]); o[2 * e + 1] = bfhi(xf[e]) + bfhi(xb[e]); ss += o[2 * e] * o[2 * e] + o[2 * e + 1] * o[2 * e + 1]; }
    ss += __shfl_xor(ss, 1); ss += __shfl_xor(ss, 2); ss += __shfl_xor(ss, 4); ss += __shfl_xor(ss, 8);
    const float rstd = 1.0f / sqrtf(ss * (1.0f / 128.0f) + EPS);
    float wv[8];
    if (type) { const f32x4 w0 = *(const f32x4*)(a.in[14] + l16 * 8), w1 = *(const f32x4*)(a.in[14] + l16 * 8 + 4);
        wv[0] = w0.x; wv[1] = w0.y; wv[2] = w0.z; wv[3] = w0.w; wv[4] = w1.x; wv[5] = w1.y; wv[6] = w1.z; wv[7] = w1.w; }
    else {
#pragma unroll
        for (int e = 0; e < 8; ++e) wv[e] = 1.0f; }
    u32x4 res;
#pragma unroll
    for (int e = 0; e < 4; ++e) { const float g0 = bflo(gg[e]), g1 = bfhi(gg[e]);
        const float s0 = g0 * __builtin_amdgcn_rcpf(1.0f + __expf(-g0)), s1 = g1 * __builtin_amdgcn_rcpf(1.0f + __expf(-g1));
        res[e] = cvtpk(o[2 * e] * rstd * wv[2 * e] * s0, o[2 * e + 1] * rstd * wv[2 * e + 1] * s1); }
    *(u32x4*)(om + off) = res;
}
__device__ __forceinline__ void phase4b(const Args& a, int row_lo, int row_hi, int wblk, int nblk) {
    const int NT = nblk * 512;
    const bf16_t* of = obase(a, 0, row_lo >= M_CTX); const bf16_t* ob = obase(a, 1, row_lo >= M_CTX);
    bf16_t* om = (bf16_t*)(a.ws + WS_OMIX);
    const int end = row_hi * 256;
#define P4B_LOAD(IDX, XF, XB, GG) do { const int l16_ = (IDX) & 15, seg_ = ((IDX) >> 4) & 15, row_ = (IDX) >> 8; const size_t off_ = (size_t)row_ * DM + seg_ * 128 + l16_ * 8; \
        const size_t offp_ = pk2_off(row_, seg_ * 128 + l16_ * 8); XF = *(const u32x4*)(of + offp_); XB = *(const u32x4*)(ob + offp_); GG = *(const u32x4*)(slotp(a, (seg_ >> 3) ? 8 : 3) + pk_off(row_, (seg_ & 7) * 128 + l16_ * 8)); } while (0)
    int idx = row_lo * 256 + wblk * 512 + threadIdx.x;
    for (; idx + NT < end; idx += 2 * NT) {
        u32x4 xf0, xb0, gg0, xf1, xb1, gg1;
        P4B_LOAD(idx, xf0, xb0, gg0); P4B_LOAD(idx + NT, xf1, xb1, gg1);
        p4b_finish(a, om, idx, xf0, xb0, gg0); p4b_finish(a, om, idx + NT, xf1, xb1, gg1);
    }
    if (idx < end) { u32x4 xf0, xb0, gg0; P4B_LOAD(idx, xf0, xb0, gg0); p4b_finish(a, om, idx, xf0, xb0, gg0); }
#undef P4B_LOAD
}

struct EpiProj {
    static constexpr bool PERM = true, AFTER_DRAIN = false;
    bf16_t* O; const LAS float* RT;
    __device__ __forceinline__ void operator()(const pg8::f32x4 (&acc)[2][2][4][2], const pg8::Unit& u, int wr, int wc, int fr, int fq) const {
        const int row0 = u.pm * 256 + wr * 64 + fr; const int slot = u.pn >> 2, colt = (u.pn & 3) * 256;
        bf16_t* base = O + (size_t)slot * ((size_t)M_ALL * 1024);
        if (u.pn >= 8) {
            const int col0 = colt + wc * 32 + 8 * fq;
#pragma unroll
            for (int ai = 0; ai < 2; ++ai)
#pragma unroll
                for (int mm = 0; mm < 4; ++mm) { bf16_t* rowp = base + pk_off(row0 + ai * 128 + mm * 16, col0);
#pragma unroll
                    for (int bj = 0; bj < 2; ++bj) { const pg8::f32x4 v0 = acc[ai][bj][mm][0], v1 = acc[ai][bj][mm][1];
                        u32x4 wv; wv.x = cvtpk(v0[0], v0[1]); wv.y = cvtpk(v0[2], v0[3]); wv.z = cvtpk(v1[0], v1[1]); wv.w = cvtpk(v1[2], v1[3]);
                        *(u32x4*)(rowp + bj * 8192) = wv; } }
        } else {
            const int part = wc >> 1, j0 = 4 * (4 * (wc & 1) + fq);
            const int lcol = colt + 64 * part + j0;
#pragma unroll
            for (int ai = 0; ai < 2; ++ai)
#pragma unroll
                for (int mm = 0; mm < 4; ++mm) { const int rr = row0 + ai * 128 + mm * 16; bf16_t* rowp = base + pk_off(rr, lcol);
                    pg8::f32x4 ca = {1.f, 0.f, 1.f, 0.f}, cb = ca;
                    if (rr >= M_CTX) { const int t = (rr - M_CTX) & 4095, pos = part ? (t & 63) : (t >> 6); const LAS float* cs = RT + (pos * 32 + j0) * 2;
                        ca = *(const LAS pg8::f32x4*)cs; cb = *(const LAS pg8::f32x4*)(cs + 4); }
#pragma unroll
                    for (int bj = 0; bj < 2; ++bj) { const pg8::f32x4 x1 = acc[ai][bj][mm][0], x2 = acc[ai][bj][mm][1];
                        u32x2 o1, o2;
                        o1.x = cvtpk(x1[0] * ca[0] - x2[0] * ca[1], x1[1] * ca[2] - x2[1] * ca[3]); o1.y = cvtpk(x1[2] * cb[0] - x2[2] * cb[1], x1[3] * cb[2] - x2[3] * cb[3]);
                        o2.x = cvtpk(x1[0] * ca[1] + x2[0] * ca[0], x1[1] * ca[3] + x2[1] * ca[2]); o2.y = cvtpk(x1[2] * cb[1] + x2[2] * cb[0], x1[3] * cb[3] + x2[3] * cb[2]);
                        *(u32x2*)(rowp + bj * 8192) = o1; *(u32x2*)(rowp + bj * 8192 + 32) = o2; } }
        }
    }
};

struct EpiResNorm {
    static constexpr bool PERM = false, AFTER_DRAIN = true;
    const float* xp; const float* xsm; float* y; const float* gate; const float* fw; unsigned* xch; unsigned* cnt; int row_off;
    __device__ __forceinline__ void fused(pg8::f32x4 (&acc)[2][2][4][2], const pg8::Unit& u, int wr, int wc, int fr, int fq, LAS unsigned char* lds, int wid, int lane) const {
        const int prow0 = row_off + u.pm * 256, panel = prow0 >> 8;
        const int m = (prow0 < M_CTX) ? 0 : 1 + ((prow0 - M_CTX) >> 12);
        const int col0 = u.pn * 256 + wc * 32 + 4 * fq;
        LAS float* P = (LAS float*)lds;
        LAS float* R = (LAS float*)(lds + 4096);
        pg8::f32x4 gv[2][2];
#pragma unroll
        for (int bj = 0; bj < 2; ++bj)
#pragma unroll
            for (int n = 0; n < 2; ++n) gv[bj][n] = *(const pg8::f32x4*)(gate + m * 2048 + col0 + bj * 128 + n * 16);
#pragma unroll
        for (int ai = 0; ai < 2; ++ai)
#pragma unroll
            for (int mm = 0; mm < 4; ++mm) { const int r = ai * 128 + wr * 64 + mm * 16 + fr, rr = prow0 + r;
                const float* xr = (rr < M_CTX ? xp + (size_t)rr * DM : xsm + (size_t)(rr - M_CTX) * DM) + col0; float sq = 0.f;
#pragma unroll
                for (int bj = 0; bj < 2; ++bj)
#pragma unroll
                    for (int n = 0; n < 2; ++n) { const pg8::f32x4 xv = *(const pg8::f32x4*)(xr + bj * 128 + n * 16); const pg8::f32x4 v = xv + gv[bj][n] * acc[ai][bj][mm][n];
                        acc[ai][bj][mm][n] = v; sq += (v[0] * v[0] + v[1] * v[1]) + (v[2] * v[2] + v[3] * v[3]); }
                sq += __shfl_xor(sq, 16); sq += __shfl_xor(sq, 32);
                if (fq == 0) P[r * 4 + wc] = sq;
                asm volatile("" : "+v"(acc[ai][0][mm][0]), "+v"(acc[ai][0][mm][1]), "+v"(acc[ai][1][mm][0]), "+v"(acc[ai][1][mm][1]));
                if (mm & 1) asm volatile("" ::: "memory"); }
        asm volatile("s_waitcnt lgkmcnt(0)" ::: "memory"); __builtin_amdgcn_s_barrier(); asm volatile("" ::: "memory");
        const int row = wid * 32 + (lane & 31);
        if (lane < 32) { const float t = (P[row * 4 + 0] + P[row * 4 + 1]) + (P[row * 4 + 2] + P[row * 4 + 3]);
            __hip_atomic_store(xch + (size_t)(prow0 + row) * 8 + u.pn, __float_as_uint(t), __ATOMIC_RELAXED, __HIP_MEMORY_SCOPE_AGENT); }
        asm volatile("s_waitcnt vmcnt(0)" ::: "memory");
        if (lane == 0) __hip_atomic_fetch_add(cnt + 64 * panel, 1u, __ATOMIC_RELAXED, __HIP_MEMORY_SCOPE_AGENT);
        if (wid == 0) { unsigned sp = 0u;
            while ((unsigned)__builtin_amdgcn_readfirstlane(__hip_atomic_load(cnt + 64 * panel, __ATOMIC_RELAXED, __HIP_MEMORY_SCOPE_AGENT)) < 64u) { __builtin_amdgcn_s_sleep(2); if (++sp > (1u << 22)) break; }
            __builtin_amdgcn_fence(__ATOMIC_ACQUIRE, "agent"); }
        asm volatile("s_waitcnt vmcnt(0) lgkmcnt(0)" ::: "memory"); __builtin_amdgcn_s_barrier(); asm volatile("" ::: "memory");
        if (lane < 32) { const unsigned* sl = xch + (size_t)(prow0 + row) * 8; float t = 0.f;
#pragma unroll
            for (int k = 0; k < 8; ++k) t += __uint_as_float(__hip_atomic_load(sl + k, __ATOMIC_RELAXED, __HIP_MEMORY_SCOPE_AGENT));
            R[row] = 1.0f / sqrtf(t * (1.0f / DM) + EPS); }
        asm volatile("s_waitcnt lgkmcnt(0)" ::: "memory"); __builtin_amdgcn_s_barrier(); asm volatile("" ::: "memory");
        pg8::f32x4 wv[2][2];
#pragma unroll
        for (int bj = 0; bj < 2; ++bj)
#pragma unroll
            for (int n = 0; n < 2; ++n) wv[bj][n] = *(const pg8::f32x4*)(fw + col0 + bj * 128 + n * 16);
#pragma unroll
        for (int ai = 0; ai < 2; ++ai)
#pragma unroll
            for (int mm = 0; mm < 4; ++mm) { const int r = ai * 128 + wr * 64 + mm * 16 + fr; const float rs = R[r]; float* yr = y + (size_t)(prow0 + r) * DM + col0;
#pragma unroll
                for (int bj = 0; bj < 2; ++bj)
#pragma unroll
                    for (int n = 0; n < 2; ++n) *(pg8::f32x4*)(yr + bj * 128 + n * 16) = acc[ai][bj][mm][n] * rs * wv[bj][n]; }
    }
};

__global__ void __launch_bounds__(512, 2) hybrid_fwd(Args a) {
    extern __shared__ __attribute__((aligned(16))) unsigned char lds_raw[];
    LAS unsigned char* lds = (LAS unsigned char*)lds_raw;
    cg::grid_group grid = cg::this_grid();
    volatile LAS unsigned* xst = (volatile LAS unsigned*)(lds + LDS_BYTES - 64);
    if (threadIdx.x < 4) xst[threadIdx.x] = 0u;
    __syncthreads();
#define GSYNC() xcd_barrier(xbar)
#ifdef PROBE_SEG
#define TS(i) do { if (blockIdx.x == 0 && threadIdx.x == 0) ((volatile LAS unsigned long long*)(lds + LDS_BYTES - 512))[i] = __builtin_amdgcn_s_memrealtime(); } while (0)
#else
#define TS(i) do { } while (0)
#endif

#define DO_P2() do {     \
        pg8::Gemm g{(const pg8::bf16_t*)a.out, (const pg8::bf16_t*)(a.ws + WS_WINT), M_ALL, NIN, DM}; \
        pg8::StaticOrder S; S.init(M_ALL, NIN, (int)gridDim.x, (int)blockIdx.x); \
        EpiProj E{(bf16_t*)(a.ws + WS_PROJ), (const LAS float*)(lds + 131072)}; \
        pg8::gemm_phase<EpiProj, pg8::StaticOrder>(lds, g, S, E, nullptr); \
        GSYNC(); } while (0)
    TS(0);
    const XcdBarrier xbar = xcd_barrier_post((unsigned*)(a.ws + WS_BAR), xst, (unsigned)gridDim.x);
    XcdBarrier cbar = xbar;
    if (blockIdx.x >= 64) cbar = xcd_barrier_post((unsigned*)(a.ws + WS_BAR2), xst + 2, (unsigned)gridDim.x - 64u);
    if (a.ws == nullptr) grid.sync();
    phase0(a, lds); GSYNC(); TS(1);
    phase0b(a); GSYNC(); TS(2);
#if REP_P0 > 1
    phase0(a, lds); GSYNC();
#endif
    phase1(a, lds); GSYNC(); TS(3);
#if REP_P1 > 1
    phase1(a, lds); GSYNC();
#endif
    { const f32x4* src = (const f32x4*)(a.ws + WS_ROPE); LAS f32x4* dst = (LAS f32x4*)(lds + 131072);
      for (int i = threadIdx.x; i < 1024; i += 512) dst[i] = src[i]; }
    __syncthreads();
    DO_P2(); TS(4);
#if REP_P2 > 1
    DO_P2();
#endif
    phase3(a, lds); GSYNC(); TS(5);
#define DO_P5N(ROW0, MROWS, GSUB, CSUB) do {     \
        pg8::Gemm g{(const pg8::bf16_t*)(a.ws + WS_OMIX) + (size_t)(ROW0) * DM, (const pg8::bf16_t*)(a.ws + WS_WOUTT), (MROWS), DM, DM}; \
        pg8::StaticOrder S; S.init((MROWS), DM, (GSUB), (CSUB)); \
        EpiResNorm E{a.in[0], a.in[1], a.out, (const float*)(a.ws + WS_GATE), a.in[16], (unsigned*)(a.ws + WS_XCH), (unsigned*)(a.ws + WS_PCNT), (ROW0)}; \
        pg8::gemm_phase<EpiResNorm, pg8::StaticOrder>(lds, g, S, E, nullptr); } while (0)
    const int G = gridDim.x, bx = blockIdx.x;
    {
        const int cb = bx - 64, ncb = G - 64; unsigned sgen = 0u; unsigned* scnt = (unsigned*)(a.ws + WS_BAR) + 3520;
#pragma unroll 1
        for (int k = 0; k < (bx < 64 ? REP_LAT : 8); ++k) { const int L = bx < 64 ? bx : bx + k * ncb; if (L >= 576) break;
            const int grp = L < 64 ? 1 : 0, ci = grp ? L : L - 64;
            chain_item(a, lds, grp, ci >> 5, (ci >> 2) & 7, (ci >> 1) & 1, ci & 1); }
        if (bx >= 64) {
            xcd_barrier(cbar);
            phase4b(a, 0, M_CTX, cb, ncb);
            xcd_barrier(cbar);
            DO_P5N(0, M_CTX, ncb, cb);
        }
        TS(6);
        GSYNC(); TS(7);
        phase4b(a, M_CTX, M_ALL, bx, G); GSYNC(); TS(8);
        DO_P5N(M_CTX, M_ALL - M_CTX, G, bx);
        TS(9);
#ifdef PROBE_SEG
        if (blockIdx.x == 0 && threadIdx.x == 0) { volatile LAS unsigned long long* ts = (volatile LAS unsigned long long*)(lds + LDS_BYTES - 512);
            const unsigned long long d = (PROBE_SEG == 99) ? ts[9] - ts[0] : ts[(PROBE_SEG % 16) + 1] - ts[PROBE_SEG % 16], t0 = __builtin_amdgcn_s_memrealtime();
            while (__builtin_amdgcn_s_memrealtime() - t0 < (unsigned long long)PROBE_MULT * d) __builtin_amdgcn_s_sleep(8); }
#endif
#ifdef REP_SYNC
#pragma unroll 1
        for (int rep = 0; rep < REP_SYNC; ++rep) GSYNC();
#endif
    }
}

extern "C" void kernel_launch(void* const* d_in, const int* in_sizes, int n_in, void* d_out, int out_size, void* d_ws, size_t ws_size, hipStream_t stream) {
    static int grid = 0;
    if (grid == 0) {
        if (n_in != 17 || ws_size < WS_END) { fprintf(stderr, "kernel_launch: needs 17 inputs and %zu bytes of workspace (got %d, %zu)\n", (size_t)WS_END, n_in, ws_size); grid = -1; return; }
        int dev = 0, cus = 0, per_cu = 0;
        hipGetDevice(&dev); hipDeviceGetAttribute(&cus, hipDeviceAttributeMultiprocessorCount, dev);
        if (hipFuncSetAttribute((const void*)hybrid_fwd, hipFuncAttributeMaxDynamicSharedMemorySize, LDS_BYTES) != hipSuccess) { fprintf(stderr, "kernel_launch: hipFuncSetAttribute failed\n"); grid = -1; return; }
        if (hipOccupancyMaxActiveBlocksPerMultiprocessor(&per_cu, (const void*)hybrid_fwd, 512, LDS_BYTES) != hipSuccess || per_cu < 1) per_cu = 1;
        (void)hipGetLastError();
        grid = cus * per_cu;
        if (grid != 256) { fprintf(stderr, "kernel_launch: built for a 256-workgroup grid (256 CUs x 1), got %d\n", grid); grid = -1; return; }
    }
    if (grid < 0) return;
    Args a{};
    for (int i = 0; i < 17; ++i) a.in[i] = (const float*)d_in[i];
    a.out = (float*)d_out; a.ws = (unsigned char*)d_ws;
    if (hipMemsetAsync((char*)d_ws + WS_BAR, 0, 16384 + 48 * 256 + 16384, stream) != hipSuccess) { fprintf(stderr, "kernel_launch: memset of barrier words failed\n"); return; }
    void* args[] = {&a};
    hipError_t e = hipLaunchCooperativeKernel((const void*)hybrid_fwd, dim3(grid), dim3(512), args, LDS_BYTES, stream);
    if (e != hipSuccess) fprintf(stderr, "cooperative launch failed: %s (grid %d)\n", hipGetErrorString(e), grid);
}
```

```cpp
#include <hip/hip_runtime.h>
#include <hip/hip_cooperative_groups.h>
#include <cstdio>
namespace pg8 {
#define PG8_LAS __attribute__((address_space(3)))
typedef unsigned short bf16_t;
typedef short bf16x8 __attribute__((ext_vector_type(8)));
typedef float f32x4 __attribute__((ext_vector_type(4)));
typedef unsigned u32x4 __attribute__((ext_vector_type(4)));
constexpr int BM = 256, BK = 64, HALF = 128, HTB = HALF * BK * 2  , STAGE_BYTES = 8 * HTB, NXCD = 8, WGM = 8;

__host__ __device__ __forceinline__ int lds_byte(int r, int c) { const int st = (r >> 4) * 2 + (c >> 5), rr = r & 15, cc = c & 31, ob = rr * 64 + cc * 2; return st * 1024 + (ob ^ (((ob >> 9) & 1) << 5)); }
__host__ __device__ __forceinline__ void stage_rc(int b, int& R, int& C) { const int st = b / 1024, sb = b % 1024, swz = sb ^ (((sb >> 9) & 1) << 5); R = (st >> 1) * 16 + swz / 64; C = (st & 1) * 32 + (swz % 64) / 2; }
__host__ __device__ __forceinline__ int perm32(int rho) { const int n = rho >> 4, i = rho & 15; return 8 * (i >> 2) + 4 * n + (i & 3); }

struct Unit { int pm, pn; };
struct Gemm { const bf16_t* A; const bf16_t* Bt; int M, N, K; };

struct StaticOrder {
    int nM, nN, nwg, G, c;
    __host__ __device__ void init(int M, int N, int G_, int c_) { nM = M / BM; nN = N / BM; nwg = nM * nN; G = G_; c = c_; }
    __host__ __device__ bool next(int i, Unit& u) const {
        const long L = (long)i * G + c; if (L >= nwg) return false;
        int wgid = (int)L; { const int q = nwg / NXCD, r = nwg % NXCD, xcd = wgid % NXCD, off = wgid / NXCD; wgid = (xcd < r ? xcd * (q + 1) : r * (q + 1) + (xcd - r) * q) + off; }
        const int nig = WGM * nN, gid = wgid / nig, fm = gid * WGM, gsz = (nM - fm) < WGM ? (nM - fm) : WGM;
        u.pm = fm + ((wgid % nig) % gsz); u.pn = (wgid % nig) / gsz; return true;
    }
    __device__ __forceinline__ void a_ready(const Unit&) const {}
    __device__ __forceinline__ void done(const Unit&) const {}
};
struct CountedOrder : StaticOrder {
    const unsigned* ready; unsigned need; unsigned* tmo;
    __device__ __forceinline__ void a_ready(const Unit& u) const {
        if (threadIdx.x < 64) {
            const unsigned long long t0 = __builtin_amdgcn_s_memrealtime(); unsigned polls = 0;
            while ((unsigned)__builtin_amdgcn_readfirstlane(__hip_atomic_load(ready + 64 * u.pm, __ATOMIC_RELAXED, __HIP_MEMORY_SCOPE_AGENT)) < need) {
                if ((++polls & 255u) == 0u && __builtin_amdgcn_readfirstlane(__hip_atomic_load(tmo, __ATOMIC_RELAXED, __HIP_MEMORY_SCOPE_AGENT)) != 0u) break;
                if (__builtin_amdgcn_s_memrealtime() - t0 > 2000000ull) {
                    if (threadIdx.x == 0) { unsigned expect = 0u; __hip_atomic_compare_exchange_strong(tmo + 1, &expect, 0x600u | (unsigned)(u.pm & 0xff), __ATOMIC_RELAXED, __ATOMIC_RELAXED, __HIP_MEMORY_SCOPE_AGENT); __hip_atomic_store(tmo, 1u, __ATOMIC_RELAXED, __HIP_MEMORY_SCOPE_AGENT); }
                    break; }
                __builtin_amdgcn_s_sleep(2); }
            __builtin_amdgcn_fence(__ATOMIC_ACQUIRE, "agent");
            asm volatile("s_waitcnt vmcnt(0)" ::: "memory");
        }
#if !defined(BROKEN_HOOK_NO_BARRIER)
        asm volatile("" ::: "memory"); __builtin_amdgcn_s_barrier(); asm volatile("" ::: "memory");
#endif
    }
};

__device__ __forceinline__ unsigned cvt_pk_bf16(float lo, float hi) { unsigned r; asm volatile("v_cvt_pk_bf16_f32 %0, %1, %2" : "=v"(r) : "v"(lo), "v"(hi)); return r; }
typedef float f32x2 __attribute__((ext_vector_type(2)));
__device__ __forceinline__ f32x2 gelu_pk(f32x2 v) {
    const f32x2 av = __builtin_elementwise_abs(v), d = av * 0.2316418882f + 1.0f;
    f32x2 t; t.x = __builtin_amdgcn_rcpf(d.x); t.y = __builtin_amdgcn_rcpf(d.y);
    f32x2 q = t * 0.5307027145f + (-0.7265760135f); q = q * t + 0.7107068705f; q = q * t + (-0.142248368f); q = q * t + 0.127414796f; q = q * t;
    const f32x2 s = (v * v) * (-0.72134752044f);
    f32x2 e; e.x = __builtin_amdgcn_exp2f(s.x); e.y = __builtin_amdgcn_exp2f(s.y);
    const f32x2 m = v * (q * e), r = v - m;
    f32x2 o; o.x = v.x < 0.f ? m.x : r.x; o.y = v.y < 0.f ? m.y : r.y; return o;
}

struct EpiF32 {
    static constexpr bool PERM = false, AFTER_DRAIN = false;
    float* C; int ldc; const float* bias;
    __device__ __forceinline__ void operator()(const f32x4 (&acc)[2][2][4][2], const Unit& u, int wr, int wc, int fr, int fq) const {
        const int row0 = u.pm * BM + wr * 64 + fr, col0 = u.pn * BM + wc * 32 + 4 * fq;
        f32x4 bv[2][2];
#pragma unroll
        for (int bj = 0; bj < 2; ++bj)
#pragma unroll
            for (int n = 0; n < 2; ++n) bv[bj][n] = bias ? *(const f32x4*)(bias + col0 + bj * HALF + n * 16) : (f32x4){0.f, 0.f, 0.f, 0.f};
#pragma unroll
        for (int ai = 0; ai < 2; ++ai)
#pragma unroll
            for (int m = 0; m < 4; ++m) { float* rowp = C + (size_t)(row0 + ai * HALF + m * 16) * ldc + col0;
#pragma unroll
                for (int bj = 0; bj < 2; ++bj)
#pragma unroll
                    for (int n = 0; n < 2; ++n) *(f32x4*)(rowp + bj * HALF + n * 16) = acc[ai][bj][m][n] + bv[bj][n]; }
    }
};
template <int ACT  > struct EpiBf16 {
    static constexpr bool PERM = true, AFTER_DRAIN = false;
    bf16_t* O; int ldc; const float* bias; int split_cols; size_t split_stride;
    __device__ __forceinline__ void operator()(const f32x4 (&acc)[2][2][4][2], const Unit& u, int wr, int wc, int fr, int fq) const {
        const int row0 = u.pm * BM + wr * 64 + fr; int colt = u.pn * BM; bf16_t* base = O;
        if (split_cols) { const int t = colt / split_cols; base += (size_t)t * split_stride; colt -= t * split_cols; }
        const int col0 = colt + wc * 32 + 8 * fq, bcol0 = u.pn * BM + wc * 32 + 8 * fq;
        f32x4 bv[2][2];
#pragma unroll
        for (int bj = 0; bj < 2; ++bj)
#pragma unroll
            for (int n = 0; n < 2; ++n) bv[bj][n] = bias ? *(const f32x4*)(bias + bcol0 + bj * HALF + 4 * n) : (f32x4){0.f, 0.f, 0.f, 0.f};
#pragma unroll
        for (int ai = 0; ai < 2; ++ai)
#pragma unroll
            for (int m = 0; m < 4; ++m) { bf16_t* rowp = base + (size_t)(row0 + ai * HALF + m * 16) * ldc + col0;
#pragma unroll
                for (int bj = 0; bj < 2; ++bj) { f32x4 v0 = acc[ai][bj][m][0] + bv[bj][0], v1 = acc[ai][bj][m][1] + bv[bj][1];
                    if (ACT == 1) { f32x2 a = gelu_pk((f32x2){v0[0], v0[1]}), b = gelu_pk((f32x2){v0[2], v0[3]}), c = gelu_pk((f32x2){v1[0], v1[1]}), d = gelu_pk((f32x2){v1[2], v1[3]});
                        v0 = (f32x4){a.x, a.y, b.x, b.y}; v1 = (f32x4){c.x, c.y, d.x, d.y}; }
                    if (ACT == 2) {
#pragma unroll
                        for (int j = 0; j < 4; ++j) { v0[j] = 0.5f * v0[j] * (1.0f + erff(v0[j] * 0.70710678f)); v1[j] = 0.5f * v1[j] * (1.0f + erff(v1[j] * 0.70710678f)); } }
                    u32x4 w; w.x = cvt_pk_bf16(v0[0], v0[1]); w.y = cvt_pk_bf16(v0[2], v0[3]); w.z = cvt_pk_bf16(v1[0], v1[1]); w.w = cvt_pk_bf16(v1[2], v1[3]);
                    *(u32x4*)(rowp + bj * HALF) = w; } }
    }
};

struct PanelStats {
    unsigned* xbuf;
    unsigned* cnt;
    unsigned* tmo;
    int ntn; float eps;
    unsigned code;
    __device__ __forceinline__ bool run(const f32x4 (&v)[2][2][4][2], const Unit& u, int wr, int wc, int fr, int fq, PG8_LAS unsigned char* lds, int wid, int lane) const {
        typedef float f32x2v __attribute__((ext_vector_type(2)));
        PG8_LAS f32x2v* P = (PG8_LAS f32x2v*)lds;
        PG8_LAS f32x2v* S = (PG8_LAS f32x2v*)(lds + 8192);
        PG8_LAS unsigned* flag = (PG8_LAS unsigned*)(lds + 8192 + 2048);
#pragma unroll
        for (int ai = 0; ai < 2; ++ai)
#pragma unroll
            for (int m = 0; m < 4; ++m) {
                float s = 0.f;
#pragma unroll
                for (int bj = 0; bj < 2; ++bj)
#pragma unroll
                    for (int n = 0; n < 2; ++n) { const f32x4 x = v[ai][bj][m][n]; s += (x[0] + x[1]) + (x[2] + x[3]); }
                s += __shfl_xor(s, 16); s += __shfl_xor(s, 32);
                const float mw = s * (1.0f / 64.0f); float q = 0.f;
#pragma unroll
                for (int bj = 0; bj < 2; ++bj)
#pragma unroll
                    for (int n = 0; n < 2; ++n) { const f32x4 d = v[ai][bj][m][n] - mw; q += (d[0] * d[0] + d[1] * d[1]) + (d[2] * d[2] + d[3] * d[3]); }
                q += __shfl_xor(q, 16); q += __shfl_xor(q, 32);
                if (fq == 0) P[(ai * HALF + wr * 64 + m * 16 + fr) * 4 + wc] = (f32x2v){mw, q};
            }
        asm volatile("s_waitcnt lgkmcnt(0)" ::: "memory"); __builtin_amdgcn_s_barrier(); asm volatile("" ::: "memory");
#if defined(BROKEN_NO_WAIT)
        if (blockIdx.x >= 64) { const long long t0 = clock64(); while (clock64() - t0 < 60000) __builtin_amdgcn_s_sleep(8); }
#endif
        const int row = wid * 32 + (lane & 31);
        if (lane < 32) {
            const f32x2v a = P[row * 4 + 0], b = P[row * 4 + 1], c = P[row * 4 + 2], d = P[row * 4 + 3];
            const float mt = (a.x + b.x + c.x + d.x) * 0.25f;
            const float da = a.x - mt, db = b.x - mt, dc = c.x - mt, dd = d.x - mt;
            const float m2 = (a.y + b.y) + (c.y + d.y) + 64.0f * ((da * da + db * db) + (dc * dc + dd * dd));
            unsigned long long* slot = (unsigned long long*)xbuf + ((size_t)(u.pm * BM + row) * 4 + u.pn);
            __hip_atomic_store(slot, ((unsigned long long)__float_as_uint(m2) << 32) | __float_as_uint(mt), __ATOMIC_RELAXED, __HIP_MEMORY_SCOPE_AGENT);
        }
        asm volatile("s_waitcnt vmcnt(0)" ::: "memory");
        if (lane == 0) __hip_atomic_fetch_add(cnt + 64 * u.pm, 1u, __ATOMIC_RELAXED, __HIP_MEMORY_SCOPE_AGENT);
        if (wid == 0) {
            bool dead = false; const unsigned long long t0 = __builtin_amdgcn_s_memrealtime(); const unsigned want = 8u * (unsigned)ntn;
            for (;;) {
#if defined(BROKEN_NO_WAIT)
                break;
#endif
                if ((unsigned)__builtin_amdgcn_readfirstlane(__hip_atomic_load(cnt + 64 * u.pm, __ATOMIC_RELAXED, __HIP_MEMORY_SCOPE_AGENT)) >= want) break;
                if (__builtin_amdgcn_s_memrealtime() - t0 > 2000000ull) {
                    if (lane == 0) { unsigned expect = 0u; __hip_atomic_compare_exchange_strong(tmo + 1, &expect, code | (unsigned)(u.pm & 0xff), __ATOMIC_RELAXED, __ATOMIC_RELAXED, __HIP_MEMORY_SCOPE_AGENT);
                                     __hip_atomic_store(tmo, 1u, __ATOMIC_RELAXED, __HIP_MEMORY_SCOPE_AGENT); }
                    dead = true; break; }
                __builtin_amdgcn_s_sleep(2);
            }
            __builtin_amdgcn_fence(__ATOMIC_ACQUIRE, "agent");
            if (lane == 0) flag[0] = dead ? 1u : 0u;
        }
        asm volatile("s_waitcnt vmcnt(0) lgkmcnt(0)" ::: "memory"); __builtin_amdgcn_s_barrier(); asm volatile("" ::: "memory");
        const bool bad = flag[0] != 0u;
        if (lane < 32) {
            const unsigned long long* slot = (const unsigned long long*)xbuf + (size_t)(u.pm * BM + row) * 4; float mt[4], m2[4]; float ms = 0.f;
#pragma unroll
            for (int t = 0; t < 4; ++t) { if (t < ntn) { const unsigned long long w = __hip_atomic_load(slot + t, __ATOMIC_RELAXED, __HIP_MEMORY_SCOPE_AGENT); mt[t] = __uint_as_float((unsigned)w); m2[t] = __uint_as_float((unsigned)(w >> 32)); } else { mt[t] = 0.f; m2[t] = 0.f; } ms += mt[t]; }
            const float mean = ms / (float)ntn; float q = 0.f;
#pragma unroll
            for (int t = 0; t < 4; ++t) if (t < ntn) { const float dm = mt[t] - mean; q += m2[t] + 256.0f * dm * dm; }
            S[row] = (f32x2v){mean, 1.0f / sqrtf(q / (256.0f * (float)ntn) + eps)};
        }
        asm volatile("s_waitcnt lgkmcnt(0)" ::: "memory"); __builtin_amdgcn_s_barrier(); asm volatile("" ::: "memory");
        return bad;
    }
};
struct EpiLnRes {
    static constexpr bool PERM = false, AFTER_DRAIN = true;
    const float* base; float* out; int ldc; const float* bias; PanelStats st; unsigned poison;
    __device__ __forceinline__ void refuse(size_t i0, size_t stride, int M, int N) const { const float q = __builtin_nanf(""); for (size_t i = i0; i < (size_t)M * N; i += stride) out[(i / N) * ldc + i % N] = q;
        if (i0 == 0) { unsigned expect = 0u; __hip_atomic_compare_exchange_strong(st.tmo + 1, &expect, 0x7f0u, __ATOMIC_RELAXED, __ATOMIC_RELAXED, __HIP_MEMORY_SCOPE_AGENT); __hip_atomic_store(st.tmo, 1u, __ATOMIC_RELAXED, __HIP_MEMORY_SCOPE_AGENT); } }
    __device__ __forceinline__ void fused(f32x4 (&acc)[2][2][4][2], const Unit& u, int wr, int wc, int fr, int fq, PG8_LAS unsigned char* lds, int wid, int lane) const {
        typedef float f32x2v __attribute__((ext_vector_type(2)));
        const PG8_LAS f32x2v* S = (const PG8_LAS f32x2v*)(lds + 8192);
        const int col0 = u.pn * BM + wc * 32 + 4 * fq;
#pragma unroll
        for (int bj = 0; bj < 2; ++bj)
#pragma unroll
            for (int n = 0; n < 2; ++n) { const f32x4 bv = bias ? *(const f32x4*)(bias + col0 + bj * HALF + n * 16) : (f32x4){0.f, 0.f, 0.f, 0.f};
#pragma unroll
                for (int ai = 0; ai < 2; ++ai)
#pragma unroll
                    for (int m = 0; m < 4; ++m) acc[ai][bj][m][n] += bv; }
        const bool bad = st.run(acc, u, wr, wc, fr, fq, lds, wid, lane) || poison != 0u;
        const float qnan = __builtin_nanf("");
#pragma unroll
        for (int ai = 0; ai < 2; ++ai)
#pragma unroll
            for (int m = 0; m < 4; ++m) { const int r = ai * HALF + wr * 64 + m * 16 + fr; const f32x2v sr = S[r]; const size_t off = (size_t)(u.pm * BM + r) * ldc + col0;
#pragma unroll
                for (int bj = 0; bj < 2; ++bj)
#pragma unroll
                    for (int n = 0; n < 2; ++n) { const f32x4 bs = *(const f32x4*)(base + off + bj * HALF + n * 16); f32x4 o = bs + (acc[ai][bj][m][n] - sr.x) * sr.y;
                        if (bad) o = (f32x4){qnan, qnan, qnan, qnan}; *(f32x4*)(out + off + bj * HALF + n * 16) = o; }
                asm volatile("" ::: "memory"); }
    }
};
struct EpiLnResLn {
    static constexpr bool PERM = false, AFTER_DRAIN = true;
    const float* base; float* out; bf16_t* xn; int ldc; const float* bias; PanelStats st1, st2; unsigned poison;
    __device__ __forceinline__ void refuse(size_t i0, size_t stride, int M, int N) const { const float q = __builtin_nanf(""); for (size_t i = i0; i < (size_t)M * N; i += stride) { const size_t o = (i / N) * ldc + i % N; out[o] = q; xn[o] = (bf16_t)0x7fc0u; }
        if (i0 == 0) { unsigned expect = 0u; __hip_atomic_compare_exchange_strong(st1.tmo + 1, &expect, 0x7f0u, __ATOMIC_RELAXED, __ATOMIC_RELAXED, __HIP_MEMORY_SCOPE_AGENT); __hip_atomic_store(st1.tmo, 1u, __ATOMIC_RELAXED, __HIP_MEMORY_SCOPE_AGENT); } }
    __device__ __forceinline__ void fused(f32x4 (&acc)[2][2][4][2], const Unit& u, int wr, int wc, int fr, int fq, PG8_LAS unsigned char* lds, int wid, int lane) const {
        typedef float f32x2v __attribute__((ext_vector_type(2))); typedef unsigned u32x2v __attribute__((ext_vector_type(2)));
        const PG8_LAS f32x2v* S = (const PG8_LAS f32x2v*)(lds + 8192);
        const int col0 = u.pn * BM + wc * 32 + 4 * fq;
#pragma unroll
        for (int bj = 0; bj < 2; ++bj)
#pragma unroll
            for (int n = 0; n < 2; ++n) { const f32x4 bv = bias ? *(const f32x4*)(bias + col0 + bj * HALF + n * 16) : (f32x4){0.f, 0.f, 0.f, 0.f};
#pragma unroll
                for (int ai = 0; ai < 2; ++ai)
#pragma unroll
                    for (int m = 0; m < 4; ++m) acc[ai][bj][m][n] += bv; }
        bool bad = st1.run(acc, u, wr, wc, fr, fq, lds, wid, lane) || poison != 0u;
        const float qnan = __builtin_nanf("");
#pragma unroll
        for (int ai = 0; ai < 2; ++ai)
#pragma unroll
            for (int m = 0; m < 4; ++m) { const int r = ai * HALF + wr * 64 + m * 16 + fr; const f32x2v sr = S[r]; const size_t off = (size_t)(u.pm * BM + r) * ldc + col0;
#pragma unroll
                for (int bj = 0; bj < 2; ++bj)
#pragma unroll
                    for (int n = 0; n < 2; ++n) { const f32x4 bs = *(const f32x4*)(base + off + bj * HALF + n * 16); acc[ai][bj][m][n] = bs + (acc[ai][bj][m][n] - sr.x) * sr.y; }
                asm volatile("" : "+v"(acc[ai][0][m][0]), "+v"(acc[ai][0][m][1]), "+v"(acc[ai][1][m][0]), "+v"(acc[ai][1][m][1]));
                if (m & 1) asm volatile("" ::: "memory"); }
        const bool bad1 = bad;
        bad = st2.run(acc, u, wr, wc, fr, fq, lds, wid, lane) || bad;
#pragma unroll
        for (int ai = 0; ai < 2; ++ai)
#pragma unroll
            for (int m = 0; m < 4; ++m) { const int r = ai * HALF + wr * 64 + m * 16 + fr; const f32x2v sr = S[r]; const size_t off = (size_t)(u.pm * BM + r) * ldc + col0;
#pragma unroll
                for (int bj = 0; bj < 2; ++bj)
#pragma unroll
                    for (int n = 0; n < 2; ++n) { const f32x4 x1 = acc[ai][bj][m][n]; *(f32x4*)(out + off + bj * HALF + n * 16) = bad1 ? (f32x4){qnan, qnan, qnan, qnan} : x1;
                        const f32x4 o = (x1 - sr.x) * sr.y; u32x2v w; w.x = cvt_pk_bf16(o[0], o[1]); w.y = cvt_pk_bf16(o[2], o[3]);
                        if (bad) { w.x = 0x7fc07fc0u; w.y = 0x7fc07fc0u; } *(u32x2v*)(xn + off + bj * HALF + n * 16) = w; }
                asm volatile("" ::: "memory"); }
    }
};

template <class Epi, class Sched, bool STAMP = false>
__device__ __forceinline__ void gemm_phase(PG8_LAS unsigned char* lds, const Gemm g, const Sched& S, const Epi& E, unsigned long long* stamps) {
    int tid_ = threadIdx.x; asm volatile("" : "+v"(tid_));
    const int tid = tid_, wid = __builtin_amdgcn_readfirstlane(tid >> 6), lane = tid & 63, wr = wid >> 2, wc = wid & 3, fr = lane & 15, fq = lane >> 4;
    const int K = g.K, nt = K / BK;
    int ts_lo = 0, ts_hi = 0, nts = 0; const unsigned long long rt_entry = STAMP ? (unsigned long long)wall_clock64() : 0ull;
#define PG8_STAMP() do { if (STAMP && wid == 0 && nts < 64) { const unsigned long long _c = (unsigned long long)clock64(); \
        ts_lo = (lane == nts) ? (int)(unsigned)_c : ts_lo; ts_hi = (lane == nts) ? (int)(unsigned)(_c >> 32) : ts_hi; ++nts; } } while (0)
    PG8_STAMP();
    unsigned voffA[2], voffB[2];
#pragma unroll
    for (int i = 0; i < 2; ++i) { int R, C; stage_rc(tid * 16 + i * 8192, R, C); const int Rb = Epi::PERM ? ((R & ~31) + perm32(R & 31)) : R;
        voffA[i] = (unsigned)(R * K + C) * 2u; voffB[i] = (unsigned)(Rb * K + C) * 2u; }
    const size_t kstep = (size_t)(BK * 2);
    const size_t hstep = (size_t)HALF * K * 2;
    const size_t tstep = 2 * hstep;
    const unsigned ldsw = (unsigned)wid * 1024u;
    const int aoff = lds_byte(wr * 64 + fr, fq * 8), boff = lds_byte(wc * 32 + fr, fq * 8);
#define PG8_SA(b, h) (((b) * 2 + (h)) * HTB)
#define PG8_SB(b, h) ((4 + (b) * 2 + (h)) * HTB)
#define PG8_STAGE(bufoff, gbase, voff) do { _Pragma("unroll") for (int _i = 0; _i < 2; ++_i) \
        __builtin_amdgcn_global_load_lds((const unsigned*)((const char*)(gbase) + (voff)[_i]), (PG8_LAS unsigned*)(lds + (bufoff) + ldsw + _i * 8192), 16, 0, 0); } while (0)
#define PG8_LDA(dst, b, h) do { _Pragma("unroll") for (int m = 0; m < 4; ++m) _Pragma("unroll") for (int k = 0; k < 2; ++k) dst[m][k] = *(const PG8_LAS bf16x8*)(lds + PG8_SA(b, h) + aoff + m * 2048 + k * 1024); } while (0)
#define PG8_LDB(dst, b, h) do { _Pragma("unroll") for (int n = 0; n < 2; ++n) _Pragma("unroll") for (int k = 0; k < 2; ++k) dst[n][k] = *(const PG8_LAS bf16x8*)(lds + PG8_SB(b, h) + boff + n * 2048 + k * 1024); } while (0)
#define PG8_MMA(ai, bj, At, Bt) do { __builtin_amdgcn_s_setprio(1); _Pragma("unroll") for (int m = 0; m < 4; ++m) _Pragma("unroll") for (int n = 0; n < 2; ++n) _Pragma("unroll") for (int k = 0; k < 2; ++k) \
        acc[ai][bj][m][n] = __builtin_amdgcn_mfma_f32_16x16x32_bf16(Bt[n][k], At[m][k], acc[ai][bj][m][n], 0, 0, 0); __builtin_amdgcn_s_setprio(0); } while (0)
#define PG8_WAIT_V(n) asm volatile("s_waitcnt vmcnt(" #n ")" ::: "memory")
#define PG8_WAIT_L(n) asm volatile("s_waitcnt lgkmcnt(" #n ")" ::: "memory")
#define PG8_BAR __builtin_amdgcn_s_barrier()
#define PG8_SCHED __builtin_amdgcn_sched_barrier(0)
    Unit cur, nxt; int ui = 0;
    if (!S.next(0, cur)) return;
    f32x4 acc[2][2][4][2];
#pragma unroll
    for (int a = 0; a < 2; ++a)
#pragma unroll
        for (int b = 0; b < 2; ++b)
#pragma unroll
            for (int m = 0; m < 4; ++m)
#pragma unroll
                for (int n = 0; n < 2; ++n) acc[a][b][m][n] = (f32x4){0.f, 0.f, 0.f, 0.f};
    bf16x8 At[4][2], B0[2][2], B1[2][2];
    const char* cA = (const char*)g.A + (size_t)cur.pm * tstep; const char* cB = (const char*)g.Bt + (size_t)cur.pn * tstep;
    S.a_ready(cur);
    PG8_STAGE(PG8_SB(0, 0), cB, voffB); PG8_STAGE(PG8_SA(0, 0), cA, voffA); PG8_STAGE(PG8_SB(0, 1), cB + hstep, voffB); PG8_STAGE(PG8_SA(0, 1), cA + hstep, voffA);
    if (wr == 1) PG8_BAR;
    PG8_WAIT_V(4); PG8_BAR;
    PG8_STAGE(PG8_SB(1, 0), cB + kstep, voffB); PG8_STAGE(PG8_SA(1, 0), cA + kstep, voffA); PG8_STAGE(PG8_SB(1, 1), cB + hstep + kstep, voffB);
    PG8_WAIT_V(6); PG8_BAR;
    PG8_STAMP();
    for (;;) {
        const bool has_next = S.next(ui + 1, nxt);
        const char* nA = has_next ? (const char*)g.A + (size_t)nxt.pm * tstep : cA; const char* nB = has_next ? (const char*)g.Bt + (size_t)nxt.pn * tstep : cB;
        for (int t = 0; t < nt; t += 2) {
            const bool last = (t == nt - 2);
            const char* a1 = cA + (size_t)(t + 1) * kstep;
            const char* a2 = last ? nA : cA + (size_t)(t + 2) * kstep; const char* b2 = last ? nB : cB + (size_t)(t + 2) * kstep;
            const char* a3 = a2 + kstep; const char* b3 = b2 + kstep;
            if (last && has_next) S.a_ready(nxt);
            PG8_LDB(B0, 0, 0); PG8_SCHED; PG8_LDA(At, 0, 0); PG8_STAGE(PG8_SA(1, 1), a1 + hstep, voffA);
            PG8_WAIT_L(8); PG8_BAR; PG8_WAIT_L(0); PG8_MMA(0, 0, At, B0); PG8_BAR; PG8_SCHED;
            PG8_LDB(B1, 0, 1); PG8_STAGE(PG8_SB(0, 0), b2, voffB);
            PG8_BAR; PG8_WAIT_L(0); PG8_MMA(0, 1, At, B1); PG8_BAR;
            PG8_LDA(At, 0, 1); PG8_STAGE(PG8_SA(0, 0), a2, voffA);
            PG8_BAR; PG8_WAIT_L(0); PG8_MMA(1, 0, At, B0); PG8_BAR; PG8_SCHED;
            PG8_STAGE(PG8_SB(0, 1), b2 + hstep, voffB);
            PG8_WAIT_V(6); PG8_BAR; PG8_MMA(1, 1, At, B1); PG8_BAR;
            PG8_LDB(B0, 1, 0); PG8_SCHED; PG8_LDA(At, 1, 0); PG8_STAGE(PG8_SA(0, 1), a2 + hstep, voffA);
            PG8_WAIT_L(8); PG8_BAR; PG8_WAIT_L(0); PG8_MMA(0, 0, At, B0); PG8_BAR; PG8_SCHED;
            PG8_LDB(B1, 1, 1); PG8_STAGE(PG8_SB(1, 0), b3, voffB);
            PG8_BAR; PG8_WAIT_L(0); PG8_MMA(0, 1, At, B1); PG8_BAR;
            PG8_LDA(At, 1, 1); PG8_STAGE(PG8_SA(1, 0), a3, voffA);
            PG8_BAR; PG8_WAIT_L(0); PG8_MMA(1, 0, At, B0); PG8_BAR; PG8_SCHED;
            PG8_STAGE(PG8_SB(1, 1), b3 + hstep, voffB);
            PG8_WAIT_V(6); PG8_BAR; PG8_MMA(1, 1, At, B1); PG8_BAR;
        }
        PG8_STAMP();
        if constexpr (!Epi::AFTER_DRAIN) { E(acc, cur, wr, wc, fr, fq); S.done(cur); }
        PG8_STAMP();
        if (!has_next) break;
#pragma unroll
        for (int a = 0; a < 2; ++a)
#pragma unroll
            for (int b = 0; b < 2; ++b)
#pragma unroll
                for (int m = 0; m < 4; ++m)
#pragma unroll
                    for (int n = 0; n < 2; ++n) acc[a][b][m][n] = (f32x4){0.f, 0.f, 0.f, 0.f};
        cur = nxt; cA = nA; cB = nB; ++ui;
    }
    PG8_WAIT_V(0);
    if (wr == 0) PG8_BAR;
    PG8_BAR;
    if constexpr (Epi::AFTER_DRAIN) { E.fused(acc, cur, wr, wc, fr, fq, lds, wid, lane); S.done(cur); }
    PG8_STAMP();
    if (STAMP && wid == 0) { stamps[lane] = lane < nts ? (((unsigned long long)(unsigned)ts_hi << 32) | (unsigned)ts_lo) : 0ull;
        if (lane == 62) stamps[62] = rt_entry; if (lane == 63) stamps[63] = (unsigned long long)wall_clock64(); }
#undef PG8_STAMP
#undef PG8_SA
#undef PG8_SB
#undef PG8_STAGE
#undef PG8_LDA
#undef PG8_LDB
#undef PG8_MMA
#undef PG8_WAIT_V
#undef PG8_WAIT_L
#undef PG8_BAR
#undef PG8_SCHED
}
}

namespace cg = cooperative_groups;
#define LAS __attribute__((address_space(3)))
typedef unsigned short bf16_t;
typedef short bf16x8 __attribute__((ext_vector_type(8)));
typedef short s16x4 __attribute__((ext_vector_type(4)));
typedef float f32x4 __attribute__((ext_vector_type(4)));
typedef float f32x16 __attribute__((ext_vector_type(16)));
typedef unsigned u32x4 __attribute__((ext_vector_type(4)));
typedef unsigned u32x2 __attribute__((ext_vector_type(2)));

constexpr int DM = 2048, M_CTX = 4096, M_ALL = 12288, NIN = 9216;
constexpr float EPS = 1e-6f;
constexpr size_t SLOT = (size_t)M_ALL * 1024 * 2;
constexpr size_t WS_PROJ = 0;
constexpr size_t WS_WINT = 9 * SLOT;
constexpr size_t WS_WOUTT = 11 * SLOT;
constexpr size_t WS_PART = WS_WOUTT + (size_t)2048 * 2048 * 2;
constexpr size_t WS_GATE = WS_PART + (size_t)16 * 3 * 6144 * 4;
constexpr size_t WS_MOD = WS_GATE + 3 * 2048 * 4;
constexpr size_t WS_EVEC = WS_MOD + 3 * 6144 * 4;
constexpr size_t WS_ROPE = WS_EVEC + (size_t)192 * 8 * 2 * 128 * 4;
constexpr size_t WS_LB = WS_ROPE + 64 * 32 * 2 * 4;
constexpr size_t WS_LG = WS_LB + 2 * 1024 * 4;
constexpr size_t WS_BAR = WS_LG + 256;
constexpr size_t WS_PCNT = WS_BAR + 16384;
constexpr size_t WS_BAR2 = WS_PCNT + 48 * 256;
constexpr size_t WS_XCH = WS_BAR2 + 16384;
constexpr size_t WS_END = WS_XCH + (size_t)M_ALL * 8 * 4;
constexpr size_t WS_OMIX = 4 * SLOT;
constexpr size_t WS_XS = 0;
constexpr int LDS_BYTES = 163840;

struct Args { const float* in[17]; float* out; unsigned char* ws; };
__device__ __forceinline__ size_t pk2_off(int row, int col) { return ((size_t)((row >> 6) * 16 + (col >> 7)) * 64 + (row & 63)) * 128 + (col & 127); }
__device__ __forceinline__ size_t pk_off(int row, int col) { return ((size_t)((row >> 6) * 8 + (col >> 7)) * 64 + (row & 63)) * 128 + (col & 127); }
#ifndef REP_LAT
#define REP_LAT 1
#endif
#ifndef REP_P0
#define REP_P0 1
#endif
#ifndef REP_P1
#define REP_P1 1
#endif
#ifndef REP_P2
#define REP_P2 1
#endif
#ifndef REP_P4
#define REP_P4 1
#endif
#ifndef REP_P4B
#define REP_P4B 1
#endif
#ifndef REP_P5
#define REP_P5 1
#endif
#ifndef REP_P6
#define REP_P6 1
#endif

__device__ __forceinline__ unsigned cvtpk(float lo, float hi) { unsigned r; asm volatile("v_cvt_pk_bf16_f32 %0, %1, %2" : "=v"(r) : "v"(lo), "v"(hi)); return r; }
__device__ __forceinline__ float bflo(unsigned u) { return __builtin_bit_cast(float, u << 16); }
__device__ __forceinline__ float bfhi(unsigned u) { return __builtin_bit_cast(float, u & 0xffff0000u); }
__device__ __forceinline__ float bf2f(bf16_t b) { return __builtin_bit_cast(float, (unsigned)b << 16); }
__device__ __forceinline__ float wave_sum(float v) {
#pragma unroll
    for (int o = 1; o < 64; o <<= 1) v += __shfl_xor(v, o);
    return v;
}
#define LDS_WAIT() asm volatile("s_waitcnt lgkmcnt(0)" ::: "memory")
#define BAR_LDS() do { asm volatile("s_waitcnt lgkmcnt(0)" ::: "memory"); __builtin_amdgcn_s_barrier(); asm volatile("" ::: "memory"); } while (0)
#define MFMA32(a, b, c) __builtin_amdgcn_mfma_f32_32x32x16_bf16((a), (b), (c), 0, 0, 0)
#define PRIO_HI() __builtin_amdgcn_s_setprio(1)
#define PRIO_LO() __builtin_amdgcn_s_setprio(0)

#define RLX_AGENT __ATOMIC_RELAXED, __HIP_MEMORY_SCOPE_AGENT
#define XB_TMO      128
#define XB_XCNT(j)  (256  + 64 * (j))
#define XB_XSUB(j)  (1280 + 64 * (j))
#define XB_XGEN(j)  (2304 + 64 * (j))
#define XB_TOP      3328
#define XB_TOPGEN   3392
#define XCD_BAR_WORDS 3456
#define XB_SPIN_CAP (1u << 18)

__device__ __forceinline__ unsigned xb_ld(unsigned* p)              { return __hip_atomic_load(p, __ATOMIC_RELAXED, __HIP_MEMORY_SCOPE_AGENT); }
__device__ __forceinline__ unsigned xb_add(unsigned* p, unsigned v) { return __hip_atomic_fetch_add(p, v, __ATOMIC_RELAXED, __HIP_MEMORY_SCOPE_AGENT); }
__device__ __forceinline__ unsigned xb_xcc_id() { return (unsigned)__builtin_amdgcn_s_getreg((3 << 11) | 20) & 0xFu; }
#define XB_SPIN(cond, bar) do { unsigned _sp = 0; while (cond) { __builtin_amdgcn_s_sleep(1); \
    if ((++_sp & 255u) == 0u) { if (xb_ld(&(bar)[XB_TMO])) break; if (_sp > XB_SPIN_CAP) { atomicAdd(&(bar)[XB_TMO], 1u); break; } } } } while (0)

struct XcdBarrier {
    unsigned* bar; unsigned x; unsigned G;
    volatile LAS unsigned* st;
};

__device__ __forceinline__ XcdBarrier xcd_barrier_post(unsigned* bar, volatile LAS unsigned* st, unsigned members) {
    XcdBarrier b; b.bar = bar; b.x = xb_xcc_id(); b.st = st; b.G = members;
    if (threadIdx.x == 0) (void)xb_add(&bar[XB_XCNT(b.x)], 1u);
    return b;
}
__device__ __forceinline__ void xcd_barrier_complete(unsigned* bar, unsigned x, unsigned G, unsigned& nloc, unsigned& nx) {
    unsigned sum, cnt, mine, sp = 0u;
    for (;;) {
        sum = 0u; cnt = 0u; mine = 0u;
#pragma unroll
        for (unsigned j = 0; j < 16; ++j) { const unsigned c = xb_ld(&bar[XB_XCNT(j)]); sum += c; cnt += (c > 0u) ? 1u : 0u; mine = (j == x) ? c : mine; }
        if (sum == G) break;
        __builtin_amdgcn_s_sleep(1);
        if ((++sp & 255u) == 0u) { if (xb_ld(&bar[XB_TMO])) break; if (sp > XB_SPIN_CAP) { atomicAdd(&bar[XB_TMO], 1u); break; } }
    }
    nloc = mine > 0u ? mine : 1u; nx = cnt > 0u ? cnt : 1u;
}

__device__ __forceinline__ void xcd_barrier(const XcdBarrier& b) {
    asm volatile("s_waitcnt vmcnt(0)" ::: "memory");
    __syncthreads();
    if (threadIdx.x == 0) {
        unsigned* bar = b.bar;
        __builtin_amdgcn_s_waitcnt(0);
        unsigned nloc = b.st[0], nx = b.st[1];
        if (nloc == 0u) { xcd_barrier_complete(bar, b.x, b.G, nloc, nx); b.st[0] = nloc; b.st[1] = nx; }
        const unsigned old = xb_add(&bar[XB_XSUB(b.x)], 1u);
        const unsigned gen = old / nloc;
        if (old + 1u == (gen + 1u) * nloc) {
            __builtin_amdgcn_fence(__ATOMIC_RELEASE, "agent");
            asm volatile("s_waitcnt vmcnt(0)" ::: "memory");
            const unsigned og = xb_add(&bar[XB_TOP], 1u);
            const unsigned tg = og / nx;
            if (og + 1u == (tg + 1u) * nx) xb_add(&bar[XB_TOPGEN], 1u);
            else XB_SPIN(xb_ld(&bar[XB_TOPGEN]) == tg, bar);
            __builtin_amdgcn_fence(__ATOMIC_ACQUIRE, "agent");
            xb_add(&bar[XB_XGEN(b.x)], 1u);
            asm volatile("s_waitcnt vmcnt(0)" ::: "memory");
        } else {
            XB_SPIN(xb_ld(&bar[XB_XGEN(b.x)]) == gen, bar);
            __builtin_amdgcn_fence(__ATOMIC_ACQUIRE, "agent");
            asm volatile("s_waitcnt vmcnt(0)" ::: "memory");
        }
    }
    __syncthreads();
}

__device__ __forceinline__ void sub_barrier(unsigned* cnt, unsigned nblk, unsigned& gen) {
    asm volatile("s_waitcnt vmcnt(0)" ::: "memory");
    __syncthreads();
    if (threadIdx.x == 0) {
        __builtin_amdgcn_fence(__ATOMIC_RELEASE, "agent");
        asm volatile("s_waitcnt vmcnt(0)" ::: "memory");
        xb_add(cnt, 1u);
        const unsigned target = (gen + 1u) * nblk; unsigned sp = 0u;
        while (xb_ld(cnt) < target) { __builtin_amdgcn_s_sleep(1); if (++sp > (1u << 22)) break; }
        __builtin_amdgcn_fence(__ATOMIC_ACQUIRE, "agent");
        asm volatile("s_waitcnt vmcnt(0)" ::: "memory");
    }
    ++gen;
    __syncthreads();
}

__device__ __forceinline__ void p0_transpose_item(const float* W, int K, int N, bf16_t* WT, LAS float* scr, int item, int lane, int sc_lo, int sc_hi, float scale, int rope_cols) {
    const int nblk = N / 32, kb = item / nblk, nb = item % nblk, k0 = 64 * kb, n0 = 32 * nb;
    const float sc = (n0 >= sc_lo && n0 < sc_hi) ? scale : 1.0f;
    {
        f32x4 t[8];
        int csrc = n0 + 4 * (lane & 7);
        if (csrc < rope_cols) { const int pp = csrc & 127; csrc = (csrc & ~127) + 64 * (pp >> 6) + 4 * ((pp >> 3) & 7) + 32 * ((pp >> 2) & 1); }
#pragma unroll
        for (int i = 0; i < 8; ++i) t[i] = __builtin_nontemporal_load((const f32x4*)(W + (size_t)(k0 + (lane >> 3) + 8 * i) * N + csrc));
#pragma unroll
        for (int i = 0; i < 8; ++i) { LAS float* d = scr + ((lane >> 3) + 8 * i) * 33 + 4 * (lane & 7); d[0] = t[i].x * sc; d[1] = t[i].y * sc; d[2] = t[i].z * sc; d[3] = t[i].w * sc; }
    }
    LDS_WAIT();
    const int c = lane & 7;
#pragma unroll
    for (int j = 0; j < 4; ++j) { const int n = (lane >> 3) + 8 * j; const LAS float* s = scr + (8 * c) * 33 + n;
        u32x4 o; o.x = cvtpk(s[0 * 33], s[1 * 33]); o.y = cvtpk(s[2 * 33], s[3 * 33]); o.z = cvtpk(s[4 * 33], s[5 * 33]); o.w = cvtpk(s[6 * 33], s[7 * 33]);
        *(u32x4*)(WT + (size_t)(n0 + n) * K + k0 + 8 * c) = o; }
    LDS_WAIT();
}
__device__ __forceinline__ void p0_gemv_task(const Args& a, int task, LAS float* scr, int lane) {
    const int cgp = task % 24, ks = task / 24;
#pragma unroll
    for (int m = 0; m < 3; ++m)
#pragma unroll
        for (int hf = 0; hf < 2; ++hf) { const int k = 128 * ks + 64 * hf + lane; const float c = (m == 0) ? a.in[7][k] : a.in[6][(m - 1) * 2048 + k];
            scr[m * 128 + 64 * hf + lane] = c / (1.0f + __expf(-c)); }
    LDS_WAIT();
    const float* w = a.in[9] + (size_t)(128 * ks) * 6144 + 256 * cgp + 4 * lane;
    f32x4 a0 = {0.f, 0.f, 0.f, 0.f}, a1 = a0, a2 = a0;
#pragma unroll 16
    for (int kk = 0; kk < 128; ++kk) { const f32x4 wv = __builtin_nontemporal_load((const f32x4*)(w + (size_t)kk * 6144)); a0 += scr[kk] * wv; a1 += scr[128 + kk] * wv; a2 += scr[256 + kk] * wv; }
    float* part = (float*)(a.ws + WS_PART) + (size_t)(ks * 3) * 6144 + 256 * cgp + 4 * lane;
    *(f32x4*)(part) = a0; *(f32x4*)(part + 6144) = a1; *(f32x4*)(part + 2 * 6144) = a2;
    LDS_WAIT();
}
__device__ __forceinline__ void phase0(const Args& a, LAS unsigned char* lds) {
    const int tid = threadIdx.x, lane = tid & 63, wave = tid >> 6;
    LAS float* scr = (LAS float*)(lds + wave * 16384);
    const int gw = blockIdx.x * 8 + wave, NGW = gridDim.x * 8;
    constexpr int T_GEMV = 24 * 16, T_WIN = 32 * (NIN / 32), T_WOUT = 32 * (2048 / 32);
    for (int t = gw; t < T_GEMV + T_WIN + T_WOUT; t += NGW) {
        const int q30 = t / 30, ng = (t + 29) / 30 < T_GEMV ? (t + 29) / 30 : T_GEMV;
        if (t % 30 == 0 && q30 < T_GEMV) { p0_gemv_task(a, q30, scr, lane); continue; }
        const int it = t - ng;
        if (it < T_WIN) p0_transpose_item(a.in[11], 2048, NIN, (bf16_t*)(a.ws + WS_WINT), scr, it, lane, 1024, 2048, 0.08838834764831845f, 2048);
        else p0_transpose_item(a.in[15], 2048, 2048, (bf16_t*)(a.ws + WS_WOUTT), scr, it - T_WIN, lane, 0, 0, 1.0f, 0);
    }
    const int gt = blockIdx.x * 512 + tid;
    if (gt < 2048) { const int pos = gt >> 5, f = gt & 31; const float fr = powf(10000.0f, -(float)f / 32.0f); const float ang = (float)pos * fr;
        float* r = (float*)(a.ws + WS_ROPE); r[2 * gt] = cosf(ang); r[2 * gt + 1] = sinf(ang); }
    else if (gt < 4096) { const int i = gt - 2048, dir = i >> 10, col = i & 1023; const float x0 = a.in[13][dir * 2048 + col], x1 = a.in[13][dir * 2048 + 1024 + col];
        ((float*)(a.ws + WS_LB))[i] = 1.0f / (1.0f + expf(x1 - x0)); }
    else if (gt < 4096 + 16) { const int i = gt - 4096; ((float*)(a.ws + WS_LG))[i] = log1pf(-expf(a.in[12][i])); }
}

__device__ __forceinline__ void phase0b(const Args& a) {
    const float* part = (const float*)(a.ws + WS_PART);
    for (int idx = blockIdx.x * 512 + threadIdx.x; idx < 3 * 6144; idx += gridDim.x * 512) { const int m = idx / 6144, c = idx % 6144; float sacc = a.in[10][c];
#pragma unroll
        for (int ks = 0; ks < 16; ++ks) sacc += part[(size_t)(ks * 3 + m) * 6144 + c];
        ((float*)(a.ws + WS_MOD))[idx] = sacc;
        if (c >= 4096) ((float*)(a.ws + WS_GATE))[m * 2048 + c - 4096] = sacc; }
}

__device__ __forceinline__ void phase1(const Args& a, LAS unsigned char* lds) {
    const int tid = threadIdx.x, lane = tid & 63, wave = tid >> 6;
    LAS float* AT = (LAS float*)lds;
    LAS float* ST = (LAS float*)(lds + 24576);
    const float* mod = (const float*)(a.ws + WS_MOD);
    for (int idx = tid; idx < 3 * 2048; idx += 512) { const int m = idx >> 11, c = idx & 2047;
        ST[idx] = mod[m * 6144 + c]; AT[idx] = a.in[8][c] * (1.0f + mod[m * 6144 + 2048 + c]); }
    __syncthreads();
    bf16_t* H = (bf16_t*)a.out;
    const int gw = blockIdx.x * 8 + wave, NGW = gridDim.x * 8;
    f32x4 vn[8];
    { const int row = gw; const float* xr = row < M_CTX ? a.in[0] + (size_t)row * DM : a.in[1] + (size_t)(row - M_CTX) * DM;
#pragma unroll
      for (int j = 0; j < 8; ++j) vn[j] = __builtin_nontemporal_load((const f32x4*)(xr + 4 * lane + 256 * j)); }
#pragma unroll 1
    for (int row = gw; row < M_ALL; row += NGW) {
        const int m = row < M_CTX ? 0 : 1 + ((row - M_CTX) >> 12);
        f32x4 v[8]; float ss = 0.f;
#pragma unroll
        for (int j = 0; j < 8; ++j) { v[j] = vn[j]; ss += (v[j].x * v[j].x + v[j].y * v[j].y) + (v[j].z * v[j].z + v[j].w * v[j].w); }
        if (row + NGW < M_ALL) { const int rn = row + NGW; const float* xr = rn < M_CTX ? a.in[0] + (size_t)rn * DM : a.in[1] + (size_t)(rn - M_CTX) * DM;
#pragma unroll
            for (int j = 0; j < 8; ++j) vn[j] = __builtin_nontemporal_load((const f32x4*)(xr + 4 * lane + 256 * j)); }
        const float rstd = 1.0f / sqrtf(wave_sum(ss) * (1.0f / DM) + EPS);
#pragma unroll
        for (int j = 0; j < 8; ++j) { const f32x4 av = *(const LAS f32x4*)(AT + m * 2048 + 4 * lane + 256 * j), sv = *(const LAS f32x4*)(ST + m * 2048 + 4 * lane + 256 * j);
            const f32x4 hv = v[j] * rstd * av + sv; u32x2 o; o.x = cvtpk(hv.x, hv.y); o.y = cvtpk(hv.z, hv.w);
            *(u32x2*)(H + (size_t)row * DM + 4 * lane + 256 * j) = o; }
    }
}

__device__ __forceinline__ bf16_t* slotp(const Args& a, int s) { return (bf16_t*)(a.ws + WS_PROJ + (size_t)s * SLOT); }
__device__ __forceinline__ bf16_t* obase(const Args& a, int dir, int lat) {
    bf16_t* o = (bf16_t*)a.out;
    return lat ? o + (size_t)2 * M_CTX * DM + (size_t)dir * (M_ALL - M_CTX) * DM - (size_t)M_CTX * DM : o + (size_t)dir * M_CTX * DM;
}
__device__ __forceinline__ float* xs_row(const Args& a, int row) {
    return row < M_CTX ? (float*)(a.ws + WS_PROJ + (size_t)(row >> 10) * SLOT + (size_t)(row & 1023) * 8192) : (float*)(a.ws + WS_XS) + (size_t)row * DM;
}
__device__ __forceinline__ void phase3(const Args& a, LAS unsigned char* lds) {
    const int tid = threadIdx.x;
    {
        const int sub = tid >> 8, dir = (tid >> 7) & 1, d = tid & 127;
        const float* LB = (const float*)(a.ws + WS_LB); float* EV = (float*)(a.ws + WS_EVEC);
        u32x4 pre[12];
#define P3_LOAD(p_) do { const int cg_ = (p_) >> 2, hp_ = (p_) & 3; \
            _Pragma("unroll") for (int u_ = 0; u_ < 12; ++u_) { const int n_ = tid + 512 * u_, tile_ = n_ >> 10, row_ = (n_ >> 4) & 63, ch_ = n_ & 15; const int sb_ = tile_ / 3, kind_ = tile_ % 3; \
                pre[u_] = *(const u32x4*)(slotp(a, 4 + kind_) + pk_off(cg_ * 64 + row_, (2 * hp_ + sb_) * 128 + ch_ * 8)); } } while (0)
        int p = blockIdx.x;
        if (p < 768) P3_LOAD(p);
        for (; p < 768; p += gridDim.x) {
            const int h = 2 * (p & 3) + sub, cgi = p >> 2, col = h * 128 + d;
            BAR_LDS();
#pragma unroll
            for (int u = 0; u < 12; ++u) *(LAS u32x4*)(lds + 16 * (tid + 512 * u)) = pre[u];
            BAR_LDS();
            if (p + (int)gridDim.x < 768) P3_LOAD(p + (int)gridDim.x);
            if (tid < 256) {
                const int sub2 = tid >> 7, dir2 = (tid >> 6) & 1, dp = tid & 63, h2 = 2 * (p & 3) + sub2, col2 = h2 * 128 + 2 * dp;
                const LAS unsigned* qt = (const LAS unsigned*)(lds + (sub2 * 3 + 0) * 16384) + dp;
                LAS unsigned* zt = (LAS unsigned*)(lds + (sub2 * 3 + 1 + dir2) * 16384) + dp;
                unsigned* qo = (unsigned*)(slotp(a, 9 + dir2) + pk_off(cgi * 64, col2));
                const float lb0 = LB[dir2 * 1024 + col2], lb1 = LB[dir2 * 1024 + col2 + 1]; float b0 = 0.f, b1 = 0.f;
#pragma unroll 1
                for (int i0 = 0; i0 < 64; i0 += 8) {
                    unsigned zz[8], qq[8]; float f0[8], f1[8], c0[8], c1[8];
#pragma unroll
                    for (int u = 0; u < 8; ++u) { const int r = dir2 ? 63 - (i0 + u) : (i0 + u); zz[u] = zt[r * 64]; qq[u] = qt[r * 64]; }
#pragma unroll
                    for (int u = 0; u < 8; ++u) {
                        const float s0 = __builtin_amdgcn_rcpf(1.0f + __builtin_amdgcn_exp2f(-1.4426950408889634f * bflo(zz[u]))), s1 = __builtin_amdgcn_rcpf(1.0f + __builtin_amdgcn_exp2f(-1.4426950408889634f * bfhi(zz[u])));
                        f0[u] = lb0 + (1.0f - lb0) * s0; f1[u] = lb1 + (1.0f - lb1) * s1; c0[u] = __builtin_amdgcn_logf(f0[u]); c1[u] = __builtin_amdgcn_logf(f1[u]); }
#pragma unroll
                    for (int u = 0; u < 8; ++u) { b0 += c0[u]; c0[u] = b0; b1 += c1[u]; c1[u] = b1; }
#pragma unroll
                    for (int u = 0; u < 8; ++u) { const int r = dir2 ? 63 - (i0 + u) : (i0 + u);
                        const float e0 = __builtin_amdgcn_exp2f(c0[u]), i0e = __builtin_amdgcn_exp2f(-c0[u]), e1 = __builtin_amdgcn_exp2f(c1[u]), i1e = __builtin_amdgcn_exp2f(-c1[u]);
                        qo[(size_t)r * 64] = cvtpk(bflo(qq[u]) * e0, bfhi(qq[u]) * e1); zt[r * 64] = cvtpk((1.0f - f0[u]) * i0e, (1.0f - f1[u]) * i1e); }
                }
                float* evp = EV + ((size_t)(cgi * 8 + h2) * 2 + dir2) * 128 + 2 * dp;
                evp[0] = __builtin_amdgcn_exp2f(b0); evp[1] = __builtin_amdgcn_exp2f(b1);
            }
            BAR_LDS();
#pragma unroll
            for (int u = 0; u < 8; ++u) { const int n = tid + 512 * u, t4 = n >> 10, row = (n >> 4) & 63, ch = n & 15; const int sb = t4 >> 1, dr = t4 & 1;
                const u32x4 v = *(const LAS u32x4*)(lds + (sb * 3 + 1 + dr) * 16384 + row * 256 + ch * 16);
                *(u32x4*)(slotp(a, 5 + dr) + pk_off(cgi * 64 + row, (2 * (p & 3) + sb) * 128 + ch * 8)) = v; }
        }
#undef P3_LOAD
        BAR_LDS();
    }
}

__device__ __forceinline__ unsigned off_b(unsigned row, unsigned ch) { return 256u * row + 16u * (ch ^ (((row & 3) << 2) | ((row >> 2) & 3))); }
__device__ __forceinline__ unsigned tr_addr(unsigned lane, unsigned c, unsigned ks, unsigned t) {
    const unsigned h = lane >> 5, blk = (lane >> 4) & 1, q = (lane & 15) >> 2, p = lane & 3;
    return off_b(16 * ks + 8 * h + 4 * t + q, 4 * c + 2 * blk + (p >> 1)) + 8 * (p & 1);
}
__device__ __forceinline__ unsigned pt_off(unsigned i, unsigned ch) { return 128u * i + 16u * (ch ^ ((i >> 1) & 7)); }
template <bool WAIT = true> __device__ __forceinline__ void tr_frag4(unsigned base, unsigned lane, unsigned c, bf16x8 (&f)[4]) {
    s16x4 r0, r1, r2, r3, r4, r5, r6, r7;
    const unsigned a0 = base + tr_addr(lane, c, 0, 0), a1 = base + tr_addr(lane, c, 0, 1);
    if (WAIT) asm volatile("ds_read_b64_tr_b16 %0, %8\n\tds_read_b64_tr_b16 %1, %9\n\tds_read_b64_tr_b16 %2, %8 offset:4096\n\tds_read_b64_tr_b16 %3, %9 offset:4096\n\t"
                 "ds_read_b64_tr_b16 %4, %8 offset:8192\n\tds_read_b64_tr_b16 %5, %9 offset:8192\n\tds_read_b64_tr_b16 %6, %8 offset:12288\n\tds_read_b64_tr_b16 %7, %9 offset:12288\n\ts_waitcnt lgkmcnt(0)"
                 : "=&v"(r0), "=&v"(r1), "=&v"(r2), "=&v"(r3), "=&v"(r4), "=&v"(r5), "=&v"(r6), "=&v"(r7)
                 : "v"(a0), "v"(a1) : "memory");
    else asm volatile("ds_read_b64_tr_b16 %0, %8\n\tds_read_b64_tr_b16 %1, %9\n\tds_read_b64_tr_b16 %2, %8 offset:4096\n\tds_read_b64_tr_b16 %3, %9 offset:4096\n\t"
                 "ds_read_b64_tr_b16 %4, %8 offset:8192\n\tds_read_b64_tr_b16 %5, %9 offset:8192\n\tds_read_b64_tr_b16 %6, %8 offset:12288\n\tds_read_b64_tr_b16 %7, %9 offset:12288"
                 : "=&v"(r0), "=&v"(r1), "=&v"(r2), "=&v"(r3), "=&v"(r4), "=&v"(r5), "=&v"(r6), "=&v"(r7)
                 : "v"(a0), "v"(a1) : "memory");
    f[0] = __builtin_shufflevector(r0, r1, 0, 1, 2, 3, 4, 5, 6, 7); f[1] = __builtin_shufflevector(r2, r3, 0, 1, 2, 3, 4, 5, 6, 7);
    f[2] = __builtin_shufflevector(r4, r5, 0, 1, 2, 3, 4, 5, 6, 7); f[3] = __builtin_shufflevector(r6, r7, 0, 1, 2, 3, 4, 5, 6, 7);
}
template <bool WAIT = true> __device__ __forceinline__ void tr_frag8(unsigned base, unsigned lane, unsigned c, bf16x8 (&f)[4], bf16x8 (&g)[4]) {
    s16x4 r0, r1, r2, r3, r4, r5, r6, r7, q0, q1, q2, q3, q4, q5, q6, q7;
    const unsigned a0 = base + tr_addr(lane, c, 0, 0), a1 = base + tr_addr(lane, c, 0, 1), b0 = base + tr_addr(lane, c + 1, 0, 0), b1 = base + tr_addr(lane, c + 1, 0, 1);
    if (WAIT) asm volatile("ds_read_b64_tr_b16 %0, %16\n\tds_read_b64_tr_b16 %1, %17\n\tds_read_b64_tr_b16 %2, %16 offset:4096\n\tds_read_b64_tr_b16 %3, %17 offset:4096\n\t"
                 "ds_read_b64_tr_b16 %4, %16 offset:8192\n\tds_read_b64_tr_b16 %5, %17 offset:8192\n\tds_read_b64_tr_b16 %6, %16 offset:12288\n\tds_read_b64_tr_b16 %7, %17 offset:12288\n\t"
                 "ds_read_b64_tr_b16 %8, %18\n\tds_read_b64_tr_b16 %9, %19\n\tds_read_b64_tr_b16 %10, %18 offset:4096\n\tds_read_b64_tr_b16 %11, %19 offset:4096\n\t"
                 "ds_read_b64_tr_b16 %12, %18 offset:8192\n\tds_read_b64_tr_b16 %13, %19 offset:8192\n\tds_read_b64_tr_b16 %14, %18 offset:12288\n\tds_read_b64_tr_b16 %15, %19 offset:12288\n\ts_waitcnt lgkmcnt(0)"
                 : "=&v"(r0), "=&v"(r1), "=&v"(r2), "=&v"(r3), "=&v"(r4), "=&v"(r5), "=&v"(r6), "=&v"(r7), "=&v"(q0), "=&v"(q1), "=&v"(q2), "=&v"(q3), "=&v"(q4), "=&v"(q5), "=&v"(q6), "=&v"(q7)
                 : "v"(a0), "v"(a1), "v"(b0), "v"(b1) : "memory");
    else asm volatile("ds_read_b64_tr_b16 %0, %16\n\tds_read_b64_tr_b16 %1, %17\n\tds_read_b64_tr_b16 %2, %16 offset:4096\n\tds_read_b64_tr_b16 %3, %17 offset:4096\n\t"
                 "ds_read_b64_tr_b16 %4, %16 offset:8192\n\tds_read_b64_tr_b16 %5, %17 offset:8192\n\tds_read_b64_tr_b16 %6, %16 offset:12288\n\tds_read_b64_tr_b16 %7, %17 offset:12288\n\t"
                 "ds_read_b64_tr_b16 %8, %18\n\tds_read_b64_tr_b16 %9, %19\n\tds_read_b64_tr_b16 %10, %18 offset:4096\n\tds_read_b64_tr_b16 %11, %19 offset:4096\n\t"
                 "ds_read_b64_tr_b16 %12, %18 offset:8192\n\tds_read_b64_tr_b16 %13, %19 offset:8192\n\tds_read_b64_tr_b16 %14, %18 offset:12288\n\tds_read_b64_tr_b16 %15, %19 offset:12288"
                 : "=&v"(r0), "=&v"(r1), "=&v"(r2), "=&v"(r3), "=&v"(r4), "=&v"(r5), "=&v"(r6), "=&v"(r7), "=&v"(q0), "=&v"(q1), "=&v"(q2), "=&v"(q3), "=&v"(q4), "=&v"(q5), "=&v"(q6), "=&v"(q7)
                 : "v"(a0), "v"(a1), "v"(b0), "v"(b1) : "memory");
    f[0] = __builtin_shufflevector(r0, r1, 0, 1, 2, 3, 4, 5, 6, 7); f[1] = __builtin_shufflevector(r2, r3, 0, 1, 2, 3, 4, 5, 6, 7);
    f[2] = __builtin_shufflevector(r4, r5, 0, 1, 2, 3, 4, 5, 6, 7); f[3] = __builtin_shufflevector(r6, r7, 0, 1, 2, 3, 4, 5, 6, 7);
    g[0] = __builtin_shufflevector(q0, q1, 0, 1, 2, 3, 4, 5, 6, 7); g[1] = __builtin_shufflevector(q2, q3, 0, 1, 2, 3, 4, 5, 6, 7);
    g[2] = __builtin_shufflevector(q4, q5, 0, 1, 2, 3, 4, 5, 6, 7); g[3] = __builtin_shufflevector(q6, q7, 0, 1, 2, 3, 4, 5, 6, 7);
}
template <bool WAIT> __device__ __forceinline__ void lds_rd8(const unsigned (&ad)[8], bf16x8 (&f)[8]) {
    if (WAIT) asm volatile("ds_read_b128 %0, %8\n\tds_read_b128 %1, %9\n\tds_read_b128 %2, %10\n\tds_read_b128 %3, %11\n\tds_read_b128 %4, %12\n\tds_read_b128 %5, %13\n\tds_read_b128 %6, %14\n\tds_read_b128 %7, %15\n\ts_waitcnt lgkmcnt(0)"
                 : "=&v"(f[0]), "=&v"(f[1]), "=&v"(f[2]), "=&v"(f[3]), "=&v"(f[4]), "=&v"(f[5]), "=&v"(f[6]), "=&v"(f[7])
                 : "v"(ad[0]), "v"(ad[1]), "v"(ad[2]), "v"(ad[3]), "v"(ad[4]), "v"(ad[5]), "v"(ad[6]), "v"(ad[7]) : "memory");
    else asm volatile("ds_read_b128 %0, %8\n\tds_read_b128 %1, %9\n\tds_read_b128 %2, %10\n\tds_read_b128 %3, %11\n\tds_read_b128 %4, %12\n\tds_read_b128 %5, %13\n\tds_read_b128 %6, %14\n\tds_read_b128 %7, %15"
                 : "=&v"(f[0]), "=&v"(f[1]), "=&v"(f[2]), "=&v"(f[3]), "=&v"(f[4]), "=&v"(f[5]), "=&v"(f[6]), "=&v"(f[7])
                 : "v"(ad[0]), "v"(ad[1]), "v"(ad[2]), "v"(ad[3]), "v"(ad[4]), "v"(ad[5]), "v"(ad[6]), "v"(ad[7]) : "memory");
}
template <bool WAIT> __device__ __forceinline__ void lds_rd4(const unsigned (&ad)[4], bf16x8 (&f)[4]) {
    if (WAIT) asm volatile("ds_read_b128 %0, %4\n\tds_read_b128 %1, %5\n\tds_read_b128 %2, %6\n\tds_read_b128 %3, %7\n\ts_waitcnt lgkmcnt(0)"
                 : "=&v"(f[0]), "=&v"(f[1]), "=&v"(f[2]), "=&v"(f[3]) : "v"(ad[0]), "v"(ad[1]), "v"(ad[2]), "v"(ad[3]) : "memory");
    else asm volatile("ds_read_b128 %0, %4\n\tds_read_b128 %1, %5\n\tds_read_b128 %2, %6\n\tds_read_b128 %3, %7"
                 : "=&v"(f[0]), "=&v"(f[1]), "=&v"(f[2]), "=&v"(f[3]) : "v"(ad[0]), "v"(ad[1]), "v"(ad[2]), "v"(ad[3]) : "memory");
}
#define LGKM_WAIT_SCHED() do { asm volatile("s_waitcnt lgkmcnt(0)" ::: "memory"); __builtin_amdgcn_sched_barrier(0); } while (0)
__device__ __forceinline__ u32x4 scale_bf8(u32x4 x, float f) {
    u32x4 o;
#pragma unroll
    for (int e = 0; e < 4; ++e) o[e] = cvtpk(bflo(x[e]) * f, bfhi(x[e]) * f);
    return o;
}

constexpr unsigned L_T = 49152, L_QT = 0, L_KT = 16384, L_VT = 32768, L_SI = 98304, L_PT = 131072, L_PTSZ = 8192, L_EV = 147456, L_EVSZ = 512, L_DUMMY = 149504;

__device__ __forceinline__ void chain_item(const Args& a, LAS unsigned char* lds, int grp, int b, int h, int type, int dir) {
    const int tid = threadIdx.x, lane = tid & 63, w = __builtin_amdgcn_readfirstlane(tid >> 6), r = lane & 31, hh = lane >> 5;
    const unsigned lbase = (unsigned)(size_t)lds;
    const int nch = grp ? 64 : 4, rowbase = grp ? M_CTX + b * 4096 : b * 256;
    const bf16_t* qs = type ? slotp(a, 9 + dir) : slotp(a, 0);
    const bf16_t* ks_ = type ? slotp(a, 5 + dir) : slotp(a, 1);
    const bf16_t* vs = type ? slotp(a, 7) : slotp(a, 2);
    const float* EVg = (const float*)(a.ws + WS_EVEC);
    bf16_t* odir = obase(a, dir, grp);
    const float lg = type ? 0.f : ((const float*)(a.ws + WS_LG))[dir * 8 + h];
    const float sdec = __expf(lg * 64.0f);
    const int lrow0 = tid >> 4, lch = tid & 15;
    const size_t gcol = (size_t)h * 128 + lch * 8;
    const int vt = w & 3, it = w >> 2, dh = w >> 2;
    float pfac = 1.f, kfac0 = 1.f, kfac1 = 1.f, qfac0 = 1.f, qfac1 = 1.f;
    if (!type) { pfac = __expf(-lg * 64.0f);
        kfac0 = __expf(lg * (float)(dir ? lrow0 : 63 - lrow0)); kfac1 = __expf(lg * (float)(dir ? lrow0 + 32 : 31 - lrow0));
        qfac0 = __expf(lg * (float)(dir ? 64 - lrow0 : lrow0 + 1)); qfac1 = __expf(lg * (float)(dir ? 32 - lrow0 : lrow0 + 33)); }
    f32x16 S0, S1;
    if (grp) { const float* s0 = a.in[2 + type * 2 + dir] + (size_t)(b * 8 + h) * 16384;
#pragma unroll
        for (int t = 0; t < 16; ++t) { const int dd = (t & 3) + 8 * (t >> 2) + 4 * hh;
            S0[t] = s0[(size_t)(64 * dh + dd) * 128 + 32 * vt + r]; S1[t] = s0[(size_t)(64 * dh + 32 + dd) * 128 + 32 * vt + r]; } }
    else {
#pragma unroll
        for (int t = 0; t < 16; ++t) { S0[t] = 0.f; S1[t] = 0.f; } }
    u32x4 pq[2], pk[2]; float pe = 0.f;
#define CH_IDX(n) (dir ? nch - 1 - (n) : (n))
#define CH_LOAD(n) do { const int c__ = CH_IDX(n); const size_t rb_ = pk_off(rowbase + 64 * c__, h * 128) + (size_t)lch * 8; \
        _Pragma("unroll") for (int u_ = 0; u_ < 2; ++u_) { const size_t o_ = rb_ + (size_t)(lrow0 + 32 * u_) * 128; \
            pq[u_] = *(const u32x4*)(qs + o_); pk[u_] = *(const u32x4*)(ks_ + o_); } \
        if (type && tid < 128) pe = EVg[((size_t)(((rowbase >> 6) + c__) * 8 + h) * 2 + dir) * 128 + tid]; } while (0)
#define CH_STORE(TB, EB) do { \
        _Pragma("unroll") for (int u_ = 0; u_ < 2; ++u_) { const int row_ = lrow0 + 32 * u_; const unsigned o_ = (TB) + off_b(row_, lch); \
            u32x4 kk_ = pk[u_], qq_ = pq[u_]; if (!type) { kk_ = scale_bf8(kk_, u_ ? kfac1 : kfac0); qq_ = scale_bf8(qq_, u_ ? qfac1 : qfac0); } \
            *(LAS u32x4*)(lds + L_QT + o_) = qq_; *(LAS u32x4*)(lds + L_KT + o_) = kk_; } \
        if (type && tid < 128) *(LAS float*)(lds + L_EV + (EB) + 4 * tid) = pe; } while (0)
#define SI_STORE() do { \
        _Pragma("unroll") for (int g_ = 0; g_ < 4; ++g_) { \
            u32x2 x0_, x1_; x0_.x = cvtpk(S0[4 * g_], S0[4 * g_ + 1]); x0_.y = cvtpk(S0[4 * g_ + 2], S0[4 * g_ + 3]); x1_.x = cvtpk(S1[4 * g_], S1[4 * g_ + 1]); x1_.y = cvtpk(S1[4 * g_ + 2], S1[4 * g_ + 3]); \
            *(LAS u32x2*)(lds + L_SI + off_b(32 * vt + r, 4 * (2 * dh) + g_) + 8 * hh) = x0_; *(LAS u32x2*)(lds + L_SI + off_b(32 * vt + r, 4 * (2 * dh + 1) + g_) + 8 * hh) = x1_; } } while (0)
#define CH_VDMA(n, TB) do { const int c__ = CH_IDX(n); const bf16_t* vb_ = vs + pk_off(rowbase + 64 * c__, h * 128); \
        _Pragma("unroll") for (int u_ = 0; u_ < 2; ++u_) { const int p_ = w + 8 * u_, row_ = 4 * p_ + (lane >> 4), cst_ = lane & 15; \
            const int ch_ = cst_ ^ (((row_ & 3) << 2) | ((row_ >> 2) & 3)); \
            const bf16_t* src_ = vb_ + row_ * 128 + ch_ * 8; \
            const unsigned dst_ = (unsigned)__builtin_amdgcn_readfirstlane((int)(lbase + L_VT + (TB) + 1024u * (unsigned)p_)); \
            asm volatile("s_mov_b32 m0, %1\n\ts_nop 0\n\tglobal_load_lds_dwordx4 %0, off" :: "v"(src_), "s"(dst_) : "memory", "m0"); } } while (0)
#define CH_SCORES(LB, TB, PB) do { if (w < 4) { \
            const int jt_ = w >> 1, it2_ = w & 1; \
            f32x16 acc_; \
            _Pragma("unroll") for (int t_ = 0; t_ < 16; ++t_) acc_[t_] = 0.f; \
            if (dir ? (jt_ >= it2_) : (it2_ >= jt_)) {     \
              const unsigned oa_ = off_b(32 * jt_ + r, hh), ob_ = off_b(32 * it2_ + r, hh); \
              _Pragma("unroll") for (int hf_ = 0; hf_ < 2; ++hf_) { bf16x8 fx_[8]; unsigned ax_[8]; \
                _Pragma("unroll") for (int s_ = 0; s_ < 4; ++s_) { ax_[s_] = (LB) + L_KT + (TB) + (oa_ ^ (32u * (4 * hf_ + s_))); ax_[4 + s_] = (LB) + L_QT + (TB) + (ob_ ^ (32u * (4 * hf_ + s_))); } \
                lds_rd8<true>(ax_, fx_); \
                __builtin_amdgcn_sched_barrier(0); \
                _Pragma("unroll") for (int s_ = 0; s_ < 4; ++s_) acc_ = MFMA32(fx_[s_], fx_[4 + s_], acc_); \
                __builtin_amdgcn_sched_barrier(0); } } \
            const int i_ = 32 * it2_ + r; \
            _Pragma("unroll") for (int g_ = 0; g_ < 4; ++g_) { float x_[4]; \
                _Pragma("unroll") for (int e_ = 0; e_ < 4; ++e_) { const int j_ = 32 * jt_ + 8 * g_ + 4 * hh + e_; const bool keep_ = dir ? (j_ >= i_) : (i_ >= j_); x_[e_] = keep_ ? acc_[4 * g_ + e_] * pfac : 0.f; } \
                u32x2 o_; o_.x = cvtpk(x_[0], x_[1]); o_.y = cvtpk(x_[2], x_[3]); \
                *(LAS u32x2*)(lds + L_PT + (PB) + pt_off(i_, 4 * jt_ + g_) + 8 * hh) = o_; } } } while (0)

    BAR_LDS();
    CH_VDMA(0, 0u); CH_VDMA(1, L_T);
    CH_LOAD(0);
    CH_STORE(0u, 0u); SI_STORE();
    CH_LOAD(1);
    BAR_LDS();
    CH_SCORES(lbase, 0u, 0u);
    CH_STORE(L_T, L_EVSZ);
    if (2 < nch) CH_LOAD(2);
    BAR_LDS();
#pragma unroll 1
    for (int step = 0; step < nch; ++step) {
        unsigned zv; asm volatile("v_mov_b32 %0, 0" : "=v"(zv));
        const unsigned lb2 = lbase + zv;
        const unsigned par = (unsigned)(step & 1), tcur = par * L_T, tnxt = L_T - tcur, pcur = par * L_PTSZ, pnxt = L_PTSZ - pcur, ecur = par * L_EVSZ;
        const int row0 = rowbase + 64 * CH_IDX(step);
#ifdef PROBE_SLEEP
        __builtin_amdgcn_s_sleep(PROBE_SLEEP);
#endif
        if (step + 1 < nch) CH_SCORES(lb2, tnxt, pnxt);
        {
            bf16x8 vf_[4], kf_[4], kg_[4];
            const unsigned os0 = off_b(32 * vt + r, hh), oq0 = off_b(32 * it + r, hh), op0 = pt_off(32 * it + r, hh);
            __builtin_amdgcn_sched_barrier(0);
            tr_frag4<false>(lb2 + L_VT + tcur, lane, vt, vf_);
            tr_frag8<true>(lb2 + L_KT + tcur, lane, 2 * dh, kf_, kg_);
            __builtin_amdgcn_sched_barrier(0);
            bf16x8 pb_[4];
            { unsigned ap_[4];
#pragma unroll
              for (int s2 = 0; s2 < 4; ++s2) ap_[s2] = lb2 + L_PT + pcur + (op0 ^ (32u * s2));
              lds_rd4<false>(ap_, pb_); }
            __builtin_amdgcn_sched_barrier(0);
            if (!type) {
#pragma unroll
                for (int t = 0; t < 16; ++t) { S0[t] *= sdec; S1[t] *= sdec; } }
#pragma unroll
            for (int s2 = 0; s2 < 4; ++s2) { S0 = MFMA32(kf_[s2], vf_[s2], S0); S1 = MFMA32(kg_[s2], vf_[s2], S1); }
            __builtin_amdgcn_sched_barrier(0);
            f32x16 o1_;
#pragma unroll
            for (int t = 0; t < 16; ++t) o1_[t] = 0.f;
            { bf16x8 sq_[8]; unsigned asq_[8];
#pragma unroll
              for (int s2 = 0; s2 < 4; ++s2) { asq_[s2] = lb2 + L_SI + (os0 ^ (32u * s2)); asq_[4 + s2] = lb2 + L_QT + tcur + (oq0 ^ (32u * s2)); }
              lds_rd8<true>(asq_, sq_);
              __builtin_amdgcn_sched_barrier(0);
#pragma unroll
              for (int s2 = 0; s2 < 4; ++s2) { o1_ = MFMA32(pb_[s2], vf_[s2], o1_); o1_ = MFMA32(sq_[4 + s2], sq_[s2], o1_); } }
            __builtin_amdgcn_sched_barrier(0);
            { bf16x8 sq2_[8]; unsigned asq_[8];
#pragma unroll
              for (int s2 = 0; s2 < 4; ++s2) { asq_[s2] = lb2 + L_SI + (os0 ^ (32u * (s2 + 4))); asq_[4 + s2] = lb2 + L_QT + tcur + (oq0 ^ (32u * (s2 + 4))); }
              lds_rd8<true>(asq_, sq2_);
              __builtin_amdgcn_sched_barrier(0);
  #pragma unroll
              for (int s2 = 0; s2 < 4; ++s2) o1_ = MFMA32(sq2_[4 + s2], sq2_[s2], o1_); }
            __builtin_amdgcn_sched_barrier(0);
            if (type) {
#pragma unroll
                for (int g = 0; g < 4; ++g) { const f32x4 e0_ = *(const LAS f32x4*)(lds + L_EV + ecur + 4 * (64 * dh + 8 * g + 4 * hh)), e1_ = *(const LAS f32x4*)(lds + L_EV + ecur + 4 * (64 * dh + 32 + 8 * g + 4 * hh));
#pragma unroll
                    for (int e = 0; e < 4; ++e) { S0[4 * g + e] *= e0_[e]; S1[4 * g + e] *= e1_[e]; } } }
            bf16_t* op_ = odir + pk2_off(row0 + 32 * it + 4 * hh, type * 1024 + h * 128 + 32 * vt + r);
#pragma unroll
            for (int t = 0; t < 16; ++t) op_[((t & 3) + 8 * (t >> 2)) * 128] = (bf16_t)(cvtpk(o1_[t], 0.f) & 0xffffu);
        }
        BAR_LDS();
        SI_STORE();
        if (step + 2 < nch) CH_STORE(tcur, ecur);
        if (step + 2 < nch) CH_VDMA(step + 2, tcur);
        if (step + 3 < nch) CH_LOAD(step + 3);
        else if (step + 1 < nch) asm volatile("s_waitcnt vmcnt(0)" ::: "memory");
        BAR_LDS();
    }
    if (!grp) {
        float* so = a.out + (size_t)M_ALL * DM + (size_t)(type * 2 + dir) * (16 * 8 * 16384) + (size_t)(b * 8 + h) * 16384;
#pragma unroll
        for (int t = 0; t < 16; ++t) { const int dd = (t & 3) + 8 * (t >> 2) + 4 * hh;
            so[(size_t)(64 * dh + dd) * 128 + 32 * vt + r] = S0[t]; so[(size_t)(64 * dh + 32 + dd) * 128 + 32 * vt + r] = S1[t]; }
    }
#undef CH_IDX
#undef CH_VDMA
#undef CH_LOAD
#undef CH_STORE
#undef SI_STORE
#undef CH_SCORES
}
__device__ __forceinline__ void p4b_finish(const Args& a, bf16_t* om, int idx, u32x4 xf, u32x4 xb, u32x4 gg) {
    const int l16 = idx & 15, seg = (idx >> 4) & 15, row = idx >> 8, type = seg >> 3;
    const size_t off = (size_t)row * DM + seg * 128 + l16 * 8;
    float o[8]; float ss = 0.f;
#pragma unroll
    for (int e = 0; e < 4; ++e) { o[2 * e] = bflo(xf[e]) + bflo(xb[e]); o[2 * e + 1] = bfhi(xf[e]) + bfhi(xb[e]); ss += o[2 * e] * o[2 * e] + o[2 * e + 1] * o[2 * e + 1]; }
    ss += __shfl_xor(ss, 1); ss += __shfl_xor(ss, 2); ss += __shfl_xor(ss, 4); ss += __shfl_xor(ss, 8);
    const float rstd = 1.0f / sqrtf(ss * (1.0f / 128.0f) + EPS);
    float wv[8];
    if (type) { const f32x4 w0 = *(const f32x4*)(a.in[14] + l16 * 8), w1 = *(const f32x4*)(a.in[14] + l16 * 8 + 4);
        wv[0] = w0.x; wv[1] = w0.y; wv[2] = w0.z; wv[3] = w0.w; wv[4] = w1.x; wv[5] = w1.y; wv[6] = w1.z; wv[7] = w1.w; }
    else {
#pragma unroll
        for (int e = 0; e < 8; ++e) wv[e] = 1.0f; }
    u32x4 res;
#pragma unroll
    for (int e = 0; e < 4; ++e) { const float g0 = bflo(gg[e]), g1 = bfhi(gg[e]);
        const float s0 = g0 * __builtin_amdgcn_rcpf(1.0f + __expf(-g0)), s1 = g1 * __builtin_amdgcn_rcpf(1.0f + __expf(-g1));
        res[e] = cvtpk(o[2 * e] * rstd * wv[2 * e] * s0, o[2 * e + 1] * rstd * wv[2 * e + 1] * s1); }
    *(u32x4*)(om + off) = res;
}
__device__ __forceinline__ void phase4b(const Args& a, int row_lo, int row_hi, int wblk, int nblk) {
    const int NT = nblk * 512;
    const bf16_t* of = obase(a, 0, row_lo >= M_CTX); const bf16_t* ob = obase(a, 1, row_lo >= M_CTX);
    bf16_t* om = (bf16_t*)(a.ws + WS_OMIX);
    const int end = row_hi * 256;
#define P4B_LOAD(IDX, XF, XB, GG) do { const int l16_ = (IDX) & 15, seg_ = ((IDX) >> 4) & 15, row_ = (IDX) >> 8; const size_t off_ = (size_t)row_ * DM + seg_ * 128 + l16_ * 8; \
        const size_t offp_ = pk2_off(row_, seg_ * 128 + l16_ * 8); XF = *(const u32x4*)(of + offp_); XB = *(const u32x4*)(ob + offp_); GG = *(const u32x4*)(slotp(a, (seg_ >> 3) ? 8 : 3) + pk_off(row_, (seg_ & 7) * 128 + l16_ * 8)); } while (0)
    int idx = row_lo * 256 + wblk * 512 + threadIdx.x;
    for (; idx + NT < end; idx += 2 * NT) {
        u32x4 xf0, xb0, gg0, xf1, xb1, gg1;
        P4B_LOAD(idx, xf0, xb0, gg0); P4B_LOAD(idx + NT, xf1, xb1, gg1);
        p4b_finish(a, om, idx, xf0, xb0, gg0); p4b_finish(a, om, idx + NT, xf1, xb1, gg1);
    }
    if (idx < end) { u32x4 xf0, xb0, gg0; P4B_LOAD(idx, xf0, xb0, gg0); p4b_finish(a, om, idx, xf0, xb0, gg0); }
#undef P4B_LOAD
}

struct EpiProj {
    static constexpr bool PERM = true, AFTER_DRAIN = false;
    bf16_t* O; const LAS float* RT;
    __device__ __forceinline__ void operator()(const pg8::f32x4 (&acc)[2][2][4][2], const pg8::Unit& u, int wr, int wc, int fr, int fq) const {
        const int row0 = u.pm * 256 + wr * 64 + fr; const int slot = u.pn >> 2, colt = (u.pn & 3) * 256;
        bf16_t* base = O + (size_t)slot * ((size_t)M_ALL * 1024);
        if (u.pn >= 8) {
            const int col0 = colt + wc * 32 + 8 * fq;
#pragma unroll
            for (int ai = 0; ai < 2; ++ai)
#pragma unroll
                for (int mm = 0; mm < 4; ++mm) { bf16_t* rowp = base + pk_off(row0 + ai * 128 + mm * 16, col0);
#pragma unroll
                    for (int bj = 0; bj < 2; ++bj) { const pg8::f32x4 v0 = acc[ai][bj][mm][0], v1 = acc[ai][bj][mm][1];
                        u32x4 wv; wv.x = cvtpk(v0[0], v0[1]); wv.y = cvtpk(v0[2], v0[3]); wv.z = cvtpk(v1[0], v1[1]); wv.w = cvtpk(v1[2], v1[3]);
                        *(u32x4*)(rowp + bj * 8192) = wv; } }
        } else {
            const int part = wc >> 1, j0 = 4 * (4 * (wc & 1) + fq);
            const int lcol = colt + 64 * part + j0;
#pragma unroll
            for (int ai = 0; ai < 2; ++ai)
#pragma unroll
                for (int mm = 0; mm < 4; ++mm) { const int rr = row0 + ai * 128 + mm * 16; bf16_t* rowp = base + pk_off(rr, lcol);
                    pg8::f32x4 ca = {1.f, 0.f, 1.f, 0.f}, cb = ca;
                    if (rr >= M_CTX) { const int t = (rr - M_CTX) & 4095, pos = part ? (t & 63) : (t >> 6); const LAS float* cs = RT + (pos * 32 + j0) * 2;
                        ca = *(const LAS pg8::f32x4*)cs; cb = *(const LAS pg8::f32x4*)(cs + 4); }
#pragma unroll
                    for (int bj = 0; bj < 2; ++bj) { const pg8::f32x4 x1 = acc[ai][bj][mm][0], x2 = acc[ai][bj][mm][1];
                        u32x2 o1, o2;
                        o1.x = cvtpk(x1[0] * ca[0] - x2[0] * ca[1], x1[1] * ca[2] - x2[1] * ca[3]); o1.y = cvtpk(x1[2] * cb[0] - x2[2] * cb[1], x1[3] * cb[2] - x2[3] * cb[3]);
                        o2.x = cvtpk(x1[0] * ca[1] + x2[0] * ca[0], x1[1] * ca[3] + x2[1] * ca[2]); o2.y = cvtpk(x1[2] * cb[1] + x2[2] * cb[0], x1[3] * cb[3] + x2[3] * cb[2]);
                        *(u32x2*)(rowp + bj * 8192) = o1; *(u32x2*)(rowp + bj * 8192 + 32) = o2; } }
        }
    }
};

struct EpiResNorm {
    static constexpr bool PERM = false, AFTER_DRAIN = true;
    const float* xp; const float* xsm; float* y; const float* gate; const float* fw; unsigned* xch; unsigned* cnt; int row_off;
    __device__ __forceinline__ void fused(pg8::f32x4 (&acc)[2][2][4][2], const pg8::Unit& u, int wr, int wc, int fr, int fq, LAS unsigned char* lds, int wid, int lane) const {
        const int prow0 = row_off + u.pm * 256, panel = prow0 >> 8;
        const int m = (prow0 < M_CTX) ? 0 : 1 + ((prow0 - M_CTX) >> 12);
        const int col0 = u.pn * 256 + wc * 32 + 4 * fq;
        LAS float* P = (LAS float*)lds;
        LAS float* R = (LAS float*)(lds + 4096);
        pg8::f32x4 gv[2][2];
#pragma unroll
        for (int bj = 0; bj < 2; ++bj)
#pragma unroll
            for (int n = 0; n < 2; ++n) gv[bj][n] = *(const pg8::f32x4*)(gate + m * 2048 + col0 + bj * 128 + n * 16);
#pragma unroll
        for (int ai = 0; ai < 2; ++ai)
#pragma unroll
            for (int mm = 0; mm < 4; ++mm) { const int r = ai * 128 + wr * 64 + mm * 16 + fr, rr = prow0 + r;
                const float* xr = (rr < M_CTX ? xp + (size_t)rr * DM : xsm + (size_t)(rr - M_CTX) * DM) + col0; float sq = 0.f;
#pragma unroll
                for (int bj = 0; bj < 2; ++bj)
#pragma unroll
                    for (int n = 0; n < 2; ++n) { const pg8::f32x4 xv = *(const pg8::f32x4*)(xr + bj * 128 + n * 16); const pg8::f32x4 v = xv + gv[bj][n] * acc[ai][bj][mm][n];
                        acc[ai][bj][mm][n] = v; sq += (v[0] * v[0] + v[1] * v[1]) + (v[2] * v[2] + v[3] * v[3]); }
                sq += __shfl_xor(sq, 16); sq += __shfl_xor(sq, 32);
                if (fq == 0) P[r * 4 + wc] = sq;
                asm volatile("" : "+v"(acc[ai][0][mm][0]), "+v"(acc[ai][0][mm][1]), "+v"(acc[ai][1][mm][0]), "+v"(acc[ai][1][mm][1]));
                if (mm & 1) asm volatile("" ::: "memory"); }
        asm volatile("s_waitcnt lgkmcnt(0)" ::: "memory"); __builtin_amdgcn_s_barrier(); asm volatile("" ::: "memory");
        const int row = wid * 32 + (lane & 31);
        if (lane < 32) { const float t = (P[row * 4 + 0] + P[row * 4 + 1]) + (P[row * 4 + 2] + P[row * 4 + 3]);
            __hip_atomic_store(xch + (size_t)(prow0 + row) * 8 + u.pn, __float_as_uint(t), __ATOMIC_RELAXED, __HIP_MEMORY_SCOPE_AGENT); }
        asm volatile("s_waitcnt vmcnt(0)" ::: "memory");
        if (lane == 0) __hip_atomic_fetch_add(cnt + 64 * panel, 1u, __ATOMIC_RELAXED, __HIP_MEMORY_SCOPE_AGENT);
        if (wid == 0) { unsigned sp = 0u;
            while ((unsigned)__builtin_amdgcn_readfirstlane(__hip_atomic_load(cnt + 64 * panel, __ATOMIC_RELAXED, __HIP_MEMORY_SCOPE_AGENT)) < 64u) { __builtin_amdgcn_s_sleep(2); if (++sp > (1u << 22)) break; }
            __builtin_amdgcn_fence(__ATOMIC_ACQUIRE, "agent"); }
        asm volatile("s_waitcnt vmcnt(0) lgkmcnt(0)" ::: "memory"); __builtin_amdgcn_s_barrier(); asm volatile("" ::: "memory");
        if (lane < 32) { const unsigned* sl = xch + (size_t)(prow0 + row) * 8; float t = 0.f;
#pragma unroll
            for (int k = 0; k < 8; ++k) t += __uint_as_float(__hip_atomic_load(sl + k, __ATOMIC_RELAXED, __HIP_MEMORY_SCOPE_AGENT));
            R[row] = 1.0f / sqrtf(t * (1.0f / DM) + EPS); }
        asm volatile("s_waitcnt lgkmcnt(0)" ::: "memory"); __builtin_amdgcn_s_barrier(); asm volatile("" ::: "memory");
        pg8::f32x4 wv[2][2];
#pragma unroll
        for (int bj = 0; bj < 2; ++bj)
#pragma unroll
            for (int n = 0; n < 2; ++n) wv[bj][n] = *(const pg8::f32x4*)(fw + col0 + bj * 128 + n * 16);
#pragma unroll
        for (int ai = 0; ai < 2; ++ai)
#pragma unroll
            for (int mm = 0; mm < 4; ++mm) { const int r = ai * 128 + wr * 64 + mm * 16 + fr; const float rs = R[r]; float* yr = y + (size_t)(prow0 + r) * DM + col0;
#pragma unroll
                for (int bj = 0; bj < 2; ++bj)
#pragma unroll
                    for (int n = 0; n < 2; ++n) *(pg8::f32x4*)(yr + bj * 128 + n * 16) = acc[ai][bj][mm][n] * rs * wv[bj][n]; }
    }
};

__global__ void __launch_bounds__(512, 2) hybrid_fwd(Args a) {
    extern __shared__ __attribute__((aligned(16))) unsigned char lds_raw[];
    LAS unsigned char* lds = (LAS unsigned char*)lds_raw;
    cg::grid_group grid = cg::this_grid();
    volatile LAS unsigned* xst = (volatile LAS unsigned*)(lds + LDS_BYTES - 64);
    if (threadIdx.x < 4) xst[threadIdx.x] = 0u;
    __syncthreads();
#define GSYNC() xcd_barrier(xbar)
#ifdef PROBE_SEG
#define TS(i) do { if (blockIdx.x == 0 && threadIdx.x == 0) ((volatile LAS unsigned long long*)(lds + LDS_BYTES - 512))[i] = __builtin_amdgcn_s_memrealtime(); } while (0)
#else
#define TS(i) do { } while (0)
#endif

#define DO_P2() do {     \
        pg8::Gemm g{(const pg8::bf16_t*)a.out, (const pg8::bf16_t*)(a.ws + WS_WINT), M_ALL, NIN, DM}; \
        pg8::StaticOrder S; S.init(M_ALL, NIN, (int)gridDim.x, (int)blockIdx.x); \
        EpiProj E{(bf16_t*)(a.ws + WS_PROJ), (const LAS float*)(lds + 131072)}; \
        pg8::gemm_phase<EpiProj, pg8::StaticOrder>(lds, g, S, E, nullptr); \
        GSYNC(); } while (0)
    TS(0);
    const XcdBarrier xbar = xcd_barrier_post((unsigned*)(a.ws + WS_BAR), xst, (unsigned)gridDim.x);
    XcdBarrier cbar = xbar;
    if (blockIdx.x >= 64) cbar = xcd_barrier_post((unsigned*)(a.ws + WS_BAR2), xst + 2, (unsigned)gridDim.x - 64u);
    if (a.ws == nullptr) grid.sync();
    phase0(a, lds); GSYNC(); TS(1);
    phase0b(a); GSYNC(); TS(2);
#if REP_P0 > 1
    phase0(a, lds); GSYNC();
#endif
    phase1(a, lds); GSYNC(); TS(3);
#if REP_P1 > 1
    phase1(a, lds); GSYNC();
#endif
    { const f32x4* src = (const f32x4*)(a.ws + WS_ROPE); LAS f32x4* dst = (LAS f32x4*)(lds + 131072);
      for (int i = threadIdx.x; i < 1024; i += 512) dst[i] = src[i]; }
    __syncthreads();
    DO_P2(); TS(4);
#if REP_P2 > 1
    DO_P2();
#endif
    phase3(a, lds); GSYNC(); TS(5);
#define DO_P5N(ROW0, MROWS, GSUB, CSUB) do {     \
        pg8::Gemm g{(const pg8::bf16_t*)(a.ws + WS_OMIX) + (size_t)(ROW0) * DM, (const pg8::bf16_t*)(a.ws + WS_WOUTT), (MROWS), DM, DM}; \
        pg8::StaticOrder S; S.init((MROWS), DM, (GSUB), (CSUB)); \
        EpiResNorm E{a.in[0], a.in[1], a.out, (const float*)(a.ws + WS_GATE), a.in[16], (unsigned*)(a.ws + WS_XCH), (unsigned*)(a.ws + WS_PCNT), (ROW0)}; \
        pg8::gemm_phase<EpiResNorm, pg8::StaticOrder>(lds, g, S, E, nullptr); } while (0)
    const int G = gridDim.x, bx = blockIdx.x;
    {
        const int cb = bx - 64, ncb = G - 64; unsigned sgen = 0u; unsigned* scnt = (unsigned*)(a.ws + WS_BAR) + 3520;
#pragma unroll 1
        for (int k = 0; k < (bx < 64 ? REP_LAT : 8); ++k) { const int L = bx < 64 ? bx : bx + k * ncb; if (L >= 576) break;
            const int grp = L < 64 ? 1 : 0, ci = grp ? L : L - 64;
            chain_item(a, lds, grp, ci >> 5, (ci >> 2) & 7, (ci >> 1) & 1, ci & 1); }
        if (bx >= 64) {
            xcd_barrier(cbar);
            phase4b(a, 0, M_CTX, cb, ncb);
            xcd_barrier(cbar);
            DO_P5N(0, M_CTX, ncb, cb);
        }
        TS(6);
        GSYNC(); TS(7);
        phase4b(a, M_CTX, M_ALL, bx, G); GSYNC(); TS(8);
        DO_P5N(M_CTX, M_ALL - M_CTX, G, bx);
        TS(9);
#ifdef PROBE_SEG
        if (blockIdx.x == 0 && threadIdx.x == 0) { volatile LAS unsigned long long* ts = (volatile LAS unsigned long long*)(lds + LDS_BYTES - 512);
            const unsigned long long d = (PROBE_SEG == 99) ? ts[9] - ts[0] : ts[(PROBE_SEG % 16) + 1] - ts[PROBE_SEG % 16], t0 = __builtin_amdgcn_s_memrealtime();
            while (__builtin_amdgcn_s_memrealtime() - t0 < (unsigned long long)PROBE_MULT * d) __builtin_amdgcn_s_sleep(8); }
#endif
#ifdef REP_SYNC
#pragma unroll 1
        for (int rep = 0; rep < REP_SYNC; ++rep) GSYNC();
#endif
    }
}

extern "C" void kernel_launch(void* const* d_in, const int* in_sizes, int n_in, void* d_out, int out_size, void* d_ws, size_t ws_size, hipStream_t stream) {
    static int grid = 0;
    if (grid == 0) {
        if (n_in != 17 || ws_size < WS_END) { fprintf(stderr, "kernel_launch: needs 17 inputs and %zu bytes of workspace (got %d, %zu)\n", (size_t)WS_END, n_in, ws_size); grid = -1; return; }
        int dev = 0, cus = 0, per_cu = 0;
        hipGetDevice(&dev); hipDeviceGetAttribute(&cus, hipDeviceAttributeMultiprocessorCount, dev);
        if (hipFuncSetAttribute((const void*)hybrid_fwd, hipFuncAttributeMaxDynamicSharedMemorySize, LDS_BYTES) != hipSuccess) { fprintf(stderr, "kernel_launch: hipFuncSetAttribute failed\n"); grid = -1; return; }
        if (hipOccupancyMaxActiveBlocksPerMultiprocessor(&per_cu, (const void*)hybrid_fwd, 512, LDS_BYTES) != hipSuccess || per_cu < 1) per_cu = 1;
        (void)hipGetLastError();
        grid = cus * per_cu;
        if (grid != 256) { fprintf(stderr, "kernel_launch: built for a 256-workgroup grid (256 CUs x 1), got %d\n", grid); grid = -1; return; }
    }
    if (grid < 0) return;
    Args a{};
    for (int i = 0; i < 17; ++i) a.in[i] = (const float*)d_in[i];
    a.out = (float*)d_out; a.ws = (unsigned char*)d_ws;
    if (hipMemsetAsync((char*)d_ws + WS_BAR, 0, 16384 + 48 * 256 + 16384, stream) != hipSuccess) { fprintf(stderr, "kernel_launch: memset of barrier words failed\n"); return; }
    void* args[] = {&a};
    hipError_t e = hipLaunchCooperativeKernel((const void*)hybrid_fwd, dim3(grid), dim3(512), args, LDS_BYTES, stream);
    if (e != hipSuccess) fprintf(stderr, "cooperative launch failed: %s (grid %d)\n", hipGetErrorString(e), grid);
}
```
